# Optimizing an MI355X kernel written in HIP

```python
import math
import jax, jax.numpy as jnp
from jax import lax
import numpy as np

D_MODEL = 1024
BATCH = 4
SEQ = 4096
DEPTH = 2

HEAD_DIM = D_MODEL // 16
A_HEADS = 4
B_HEADS = 4
C_HEADS = 8
C_KV_HEADS = 2
DIFF_DK = HEAD_DIM // 2
DIFF_DV = HEAD_DIM
CMP_LEN = 32
CMP_STRIDE = 16
CMP_HIDDEN = 2 * HEAD_DIM
SLC_BLOCK = 64
SLC_TOPN = 16
NSA_WINDOW = 512
SWA_WINDOW = 128
QBLK = 128
N_EXPERTS = 8
TOP_K = 2
D_FF_EXPERT = 7 * D_MODEL // 2
D_FF_DENSE = 2816
MOE_BLK = 256
PLE_DIM = 256
LN_EPS = 1e-5
NEG_INF = -1e30
FORCE_SCORE = 1e9
DN_ALPHA = (2 * DEPTH) ** 0.25
DN_BETA = (8 * DEPTH) ** -0.25
N_DENSE = (DEPTH + 1) // 2
N_MOE = DEPTH // 2
PROJ_SIZES = (A_HEADS * HEAD_DIM, 6 * HEAD_DIM, 3 * A_HEADS,
              B_HEADS * 2 * DIFF_DK, B_HEADS * 2 * DIFF_DK, B_HEADS * DIFF_DV,
              C_HEADS * HEAD_DIM, C_KV_HEADS * HEAD_DIM, C_KV_HEADS * HEAD_DIM)
N_PROJ = sum(PROJ_SIZES)

kernel_name = 'hybrid_nsa_diff_swa_moe_deepnorm'


def layer_norm(x, g, b):
    xf = x.astype(jnp.float32)
    mu = jnp.mean(xf, axis=-1, keepdims=True)
    var = jnp.mean(jnp.square(xf - mu), axis=-1, keepdims=True)
    return ((xf - mu) * lax.rsqrt(var + LN_EPS) * g + b).astype(x.dtype)


def rms_norm(x, g):
    xf = x.astype(jnp.float32)
    y = xf * lax.rsqrt(jnp.mean(jnp.square(xf), axis=-1, keepdims=True) + LN_EPS) * g
    return y.astype(x.dtype)


def masked_softmax(s, mask):
    s = jnp.where(mask, s.astype(jnp.float32), NEG_INF)
    m = jnp.max(s, axis=-1, keepdims=True)
    e = jnp.where(mask, jnp.exp(s - m), 0.0)
    return e / jnp.maximum(jnp.sum(e, axis=-1, keepdims=True), 1e-30)


def sink_softmax(s, mask, sink):
    s = jnp.where(mask, s.astype(jnp.float32), NEG_INF)
    sink = sink.astype(jnp.float32)
    m = jnp.maximum(jnp.max(s, axis=-1, keepdims=True), sink)
    e = jnp.where(mask, jnp.exp(s - m), 0.0)
    return e / (jnp.sum(e, axis=-1, keepdims=True) + jnp.exp(sink - m))


def alibi_slopes():
    n = A_HEADS + B_HEADS + C_HEADS
    s = 2.0 ** (-8.0 * jnp.arange(1, n + 1, dtype=jnp.float32) / n)
    rest = s[C_HEADS:]
    return rest[0::2], rest[1::2], s[:C_HEADS]


def band_blocks(a, n_prev):
    B, T = a.shape[:2]
    nb = T // QBLK
    pad = [(0, 0), (n_prev * QBLK, 0)] + [(0, 0)] * (a.ndim - 2)
    c = jnp.pad(a, pad).reshape(B, nb + n_prev, QBLK, *a.shape[2:])
    return jnp.concatenate([c[:, i:i + nb] for i in range(n_prev + 1)], axis=2)


def banded_attention(q, k, v, window, slopes, sinks):
    B, T, G, R, dh = q.shape
    nb = T // QBLK
    n_prev = window // QBLK
    kw = (n_prev + 1) * QBLK
    kb = band_blocks(k, n_prev)
    vb = band_blocks(v, n_prev)
    qb = q.reshape(B, nb, QBLK, G, R, dh)
    qq = jnp.arange(QBLK)[:, None]
    kk = jnp.arange(kw)[None, :]
    dist = n_prev * QBLK + qq - kk
    s_pos = (jnp.arange(nb)[:, None, None] - n_prev) * QBLK + kk[None]
    mask = (((dist >= 0) & (dist < window))[None] & (s_pos >= 0))[None, :, None, None]
    s = jnp.einsum('bnqgrd,bnkgd->bngrqk', qb, kb).astype(jnp.float32) * (dh ** -0.5)
    s = s - slopes[:, :, None, None] * dist.astype(jnp.float32)
    if sinks is None:
        p = masked_softmax(s, mask)
    else:
        p = sink_softmax(s, mask, sinks[:, :, None, None])
    o = jnp.einsum('bngrqk,bnkgd->bnqgrd', p.astype(v.dtype), vb)
    return o.reshape(B, T, G, R, dh)


def compress_blocks(kv, pos, w1, w2):
    B, T, dh = kv.shape
    n_chunk = T // CMP_STRIDE
    r = CMP_LEN // CMP_STRIDE
    n_cmp = n_chunk - r + 1
    c = kv.reshape(B, n_chunk, CMP_STRIDE, dh)
    blocks = jnp.concatenate([c[:, i:i + n_cmp] for i in range(r)], axis=2) + pos
    h = jax.nn.gelu(blocks.reshape(B, n_cmp, CMP_LEN * dh) @ w1)
    return h @ w2


def selected_attention(q, k, v, idx, slopes):
    B, T, H, dh = q.shape
    n = idx.shape[-1]
    nsl = T // SLC_BLOCK
    nq = T // QBLK
    kb = k.reshape(B, nsl, SLC_BLOCK, dh)
    vb = v.reshape(B, nsl, SLC_BLOCK, dh)
    qc = q.reshape(B, nq, QBLK, H, dh).transpose(1, 0, 2, 3, 4)
    ic = idx.reshape(B, nq, QBLK, n).transpose(1, 0, 2, 3)
    bidx = jnp.arange(B)[:, None, None]
    off = jnp.arange(SLC_BLOCK)

    def one(args):
        qj, ij, j = args
        kg = kb[bidx, ij].reshape(B, QBLK, n * SLC_BLOCK, dh)
        vg = vb[bidx, ij].reshape(B, QBLK, n * SLC_BLOCK, dh)
        s_pos = (ij[..., None] * SLC_BLOCK + off).reshape(B, QBLK, n * SLC_BLOCK)
        dist = (j * QBLK + jnp.arange(QBLK))[None, :, None] - s_pos
        s = jnp.einsum('bqhd,bqkd->bqhk', qj, kg).astype(jnp.float32) * (dh ** -0.5)
        s = s - slopes[None, None, :, None] * dist.astype(jnp.float32)[:, :, None, :]
        p = masked_softmax(s, (dist >= 0)[:, :, None, :])
        return jnp.einsum('bqhk,bqkd->bqhd', p.astype(vg.dtype), vg)

    o = lax.map(one, (qc, ic, jnp.arange(nq)))
    return o.transpose(1, 0, 2, 3, 4).reshape(B, T, H, dh)


def nsa_mixer(q, k_cmp, v_cmp, k_slc, v_slc, k_win, v_win, gates, cmp_pos, cmp_w1, cmp_w2, slopes):
    B, T, H, dh = q.shape
    kc = compress_blocks(k_cmp, cmp_pos[0], cmp_w1[0], cmp_w2[0])
    vc = compress_blocks(v_cmp, cmp_pos[1], cmp_w1[1], cmp_w2[1])
    n_cmp = kc.shape[1]
    t = jnp.arange(T)
    c_start = jnp.arange(n_cmp) * CMP_STRIDE
    dist_c = (t[:, None] - (c_start + CMP_LEN - 1)[None, :]).astype(jnp.float32)
    s_c = jnp.einsum('bthd,bnd->bthn', q, kc).astype(jnp.float32) * (dh ** -0.5)
    s_c = s_c - slopes[None, :, None] * dist_c[:, None, :]
    p_c = masked_softmax(s_c, (dist_c >= 0)[:, None, :])
    o_c = jnp.einsum('bthn,bnd->bthd', p_c.astype(vc.dtype), vc)
    nsl = T // SLC_BLOCK
    s_start = jnp.arange(nsl) * SLC_BLOCK
    overlap = jnp.clip(jnp.minimum(c_start[:, None] + CMP_LEN, s_start[None, :] + SLC_BLOCK)
                       - jnp.maximum(c_start[:, None], s_start[None, :]), 0, None).astype(jnp.float32) / CMP_LEN
    imp = jnp.einsum('bthn,nj->btj', p_c, overlap)
    t_blk = t // SLC_BLOCK
    j = jnp.arange(nsl)
    forced = (j[None] == 0) | (j[None] == t_blk[:, None]) | (j[None] == t_blk[:, None] - 1)
    future = j[None] > t_blk[:, None]
    imp = jnp.where(forced[None], FORCE_SCORE, jnp.where(future[None], -1.0, imp))
    _, idx = lax.top_k(imp, min(SLC_TOPN, nsl))
    o_s = selected_attention(q, k_slc, v_slc, idx, slopes)
    o_w = banded_attention(q[:, :, None], k_win[:, :, None], v_win[:, :, None],
                           NSA_WINDOW, slopes[None], None)[:, :, 0]
    o = gates[..., 0:1] * o_c + gates[..., 1:2] * o_s + gates[..., 2:3] * o_w
    return o.reshape(B, T, H * dh)


def diff_attention(q, k, v, lam, slopes):
    B, T, H, _, dk = q.shape
    nq = T // QBLK
    qc = q.reshape(B, nq, QBLK, H, 2, dk).transpose(1, 0, 2, 3, 4, 5)
    s_pos = jnp.arange(T)

    def one(args):
        qj, j = args
        dist = (j * QBLK + jnp.arange(QBLK))[:, None] - s_pos[None, :]
        bias = -slopes[:, None, None] * dist.astype(jnp.float32)
        s = jnp.einsum('bqhcd,bkhcd->bchqk', qj, k).astype(jnp.float32) * (dk ** -0.5) + bias
        p = masked_softmax(s, dist >= 0)
        w = p[:, 0] - lam * p[:, 1]
        return jnp.einsum('bhqk,bkhd->bqhd', w.astype(v.dtype), v)

    o = lax.map(one, (qc, jnp.arange(nq)))
    return o.transpose(1, 0, 2, 3, 4).reshape(B, T, H, -1)


def swiglu(h, wg, wu, wd):
    return (jax.nn.silu(h @ wg) * (h @ wu)) @ wd


def moe_swiglu(x, w_router, w_gate, w_up, w_down):
    B, T, D = x.shape
    n_tok = B * T
    xf = x.reshape(n_tok, D)
    logits = (xf @ w_router).astype(jnp.float32)
    top_logit, top_e = lax.top_k(logits, TOP_K)
    gate = jax.nn.softmax(top_logit, axis=-1)
    n_asg = n_tok * TOP_K
    e_flat = top_e.reshape(n_asg)
    tok_flat = jnp.arange(n_asg) // TOP_K
    g_flat = gate.reshape(n_asg)
    order = jnp.argsort(e_flat)
    e_sorted = e_flat[order]
    counts = jnp.bincount(e_flat, length=N_EXPERTS)
    padded = (counts + MOE_BLK - 1) // MOE_BLK * MOE_BLK
    pad_end = jnp.cumsum(padded)
    start = jnp.cumsum(counts) - counts
    dest = pad_end[e_sorted] - padded[e_sorted] + jnp.arange(n_asg) - start[e_sorted]
    n_blk = -(-n_asg // MOE_BLK) + N_EXPERTS
    cap = n_blk * MOE_BLK
    tok_buf = jnp.zeros((cap,), jnp.int32).at[dest].set(tok_flat[order])
    g_buf = jnp.zeros((cap,), jnp.float32).at[dest].set(g_flat[order])
    blk_e = jnp.minimum(jnp.sum(pad_end[None, :] <= (jnp.arange(n_blk) * MOE_BLK)[:, None], axis=-1),
                        N_EXPERTS - 1)
    x_buf = xf[tok_buf].reshape(n_blk, MOE_BLK, D)

    def expert_block(args):
        xb, e = args
        return swiglu(xb, w_gate[e], w_up[e], w_down[e])

    y = lax.map(expert_block, (x_buf, blk_e)).reshape(cap, D)
    out = jnp.zeros((n_tok, D), jnp.float32).at[tok_buf].add(y.astype(jnp.float32) * g_buf[:, None])
    return out.astype(x.dtype).reshape(B, T, D)


def setup_inputs(seed: int = 0) -> dict:
    key = jax.random.key(seed)
    keys = iter(jax.random.split(key, 32))

    def nrm(shape, scale):
        return jax.random.normal(next(keys), shape, jnp.float32) * scale

    D = D_MODEL
    return {
        'x': nrm((BATCH, SEQ, D), 1.0),
        'p': nrm((DEPTH, BATCH, SEQ, PLE_DIM), 1.0),
        'w_in': nrm((DEPTH, D, N_PROJ), D ** -0.5),
        'cmp_pos': nrm((DEPTH, 2, CMP_LEN, HEAD_DIM), 0.1),
        'cmp_w1': nrm((DEPTH, 2, CMP_LEN * HEAD_DIM, CMP_HIDDEN), (CMP_LEN * HEAD_DIM) ** -0.5),
        'cmp_w2': nrm((DEPTH, 2, CMP_HIDDEN, HEAD_DIM), CMP_HIDDEN ** -0.5),
        'diff_lambda': nrm((DEPTH, 4, DIFF_DK), 0.1),
        'diff_subln': 1.0 + nrm((DEPTH, DIFF_DV), 0.1),
        'sinks': nrm((DEPTH, C_HEADS), 1.0),
        'w_out': nrm((DEPTH, D, D), D ** -0.5 * DN_BETA),
        'ln1_g': 1.0 + nrm((DEPTH, D), 0.1),
        'ln1_b': nrm((DEPTH, D), 0.02),
        'ffn_w_gate': nrm((N_DENSE, D, D_FF_DENSE), D ** -0.5),
        'ffn_w_up': nrm((N_DENSE, D, D_FF_DENSE), D ** -0.5),
        'ffn_w_down': nrm((N_DENSE, D_FF_DENSE, D), D_FF_DENSE ** -0.5 * DN_BETA),
        'moe_router': nrm((N_MOE, D, N_EXPERTS), D ** -0.5),
        'moe_w_gate': nrm((N_MOE, N_EXPERTS, D, D_FF_EXPERT), D ** -0.5),
        'moe_w_up': nrm((N_MOE, N_EXPERTS, D, D_FF_EXPERT), D ** -0.5),
        'moe_w_down': nrm((N_MOE, N_EXPERTS, D_FF_EXPERT, D), D_FF_EXPERT ** -0.5 * DN_BETA),
        'ln2_g': 1.0 + nrm((DEPTH, D), 0.1),
        'ln2_b': nrm((DEPTH, D), 0.02),
        'ple_gate': nrm((DEPTH, D, D), D ** -0.5),
        'ple_proj': nrm((DEPTH, PLE_DIM, D), PLE_DIM ** -0.5 * DN_BETA),
        'ln3_g': 1.0 + nrm((DEPTH, D), 0.1),
        'ln3_b': nrm((DEPTH, D), 0.02),
    }


def reference(x, p, w_in, cmp_pos, cmp_w1, cmp_w2, diff_lambda, diff_subln, sinks, w_out,
              ln1_g, ln1_b, ffn_w_gate, ffn_w_up, ffn_w_down, moe_router, moe_w_gate, moe_w_up,
              moe_w_down, ln2_g, ln2_b, ple_gate, ple_proj, ln3_g, ln3_b):
    B, T, _ = x.shape
    slopes_a, slopes_b, slopes_c = alibi_slopes()
    offs = np.cumsum(PROJ_SIZES)[:-1].tolist()
    for i in range(DEPTH):
        proj = jnp.einsum('btd,dn->btn', x, w_in[i])
        q_a, kv_a, g_a, q_b, k_b, v_b, q_c, k_c, v_c = jnp.split(proj, offs, axis=-1)
        kv_a = kv_a.reshape(B, T, 6, HEAD_DIM)
        o_a = nsa_mixer(q_a.reshape(B, T, A_HEADS, HEAD_DIM),
                        kv_a[:, :, 0], kv_a[:, :, 1], kv_a[:, :, 2], kv_a[:, :, 3], kv_a[:, :, 4], kv_a[:, :, 5],
                        jax.nn.sigmoid(g_a).reshape(B, T, A_HEADS, 3),
                        cmp_pos[i], cmp_w1[i], cmp_w2[i], slopes_a)
        lam_init = 0.8 - 0.6 * math.exp(-0.3 * i)
        dl = diff_lambda[i].astype(jnp.float32)
        lam = jnp.exp(jnp.sum(dl[0] * dl[1])) - jnp.exp(jnp.sum(dl[2] * dl[3])) + lam_init
        o_b = diff_attention(q_b.reshape(B, T, B_HEADS, 2, DIFF_DK), k_b.reshape(B, T, B_HEADS, 2, DIFF_DK),
                             v_b.reshape(B, T, B_HEADS, DIFF_DV), lam, slopes_b)
        o_b = rms_norm(o_b, diff_subln[i]) * (1.0 - lam_init)
        o_c = banded_attention(q_c.reshape(B, T, C_KV_HEADS, C_HEADS // C_KV_HEADS, HEAD_DIM),
                               k_c.reshape(B, T, C_KV_HEADS, HEAD_DIM), v_c.reshape(B, T, C_KV_HEADS, HEAD_DIM),
                               SWA_WINDOW, slopes_c.reshape(C_KV_HEADS, -1), sinks[i].reshape(C_KV_HEADS, -1))
        mix = jnp.concatenate([o_a, o_b.reshape(B, T, -1), o_c.reshape(B, T, -1)], axis=-1) @ w_out[i]
        x = layer_norm(DN_ALPHA * x + mix, ln1_g[i], ln1_b[i])
        if i % 2 == 0:
            f = swiglu(x, ffn_w_gate[i // 2], ffn_w_up[i // 2], ffn_w_down[i // 2])
        else:
            f = moe_swiglu(x, moe_router[i // 2], moe_w_gate[i // 2], moe_w_up[i // 2], moe_w_down[i // 2])
        x = layer_norm(DN_ALPHA * x + f, ln2_g[i], ln2_b[i])
        e = jax.nn.sigmoid(x @ ple_gate[i]) * (p[i] @ ple_proj[i])
        x = layer_norm(DN_ALPHA * x + e, ln3_g[i], ln3_b[i])
    return x
```

```cpp
#include <hip/hip_runtime.h>
#include <hip/hip_bf16.h>
#include <cstdint>
#include <cstdio>

#define GAS __attribute__((address_space(1)))
#define LAS __attribute__((address_space(3)))
typedef unsigned short bf16_t;
typedef short bf16x8 __attribute__((ext_vector_type(8)));
typedef short s16x4 __attribute__((ext_vector_type(4)));
typedef float f32x2 __attribute__((ext_vector_type(2)));
typedef float f32x4 __attribute__((ext_vector_type(4)));
typedef float f32x16 __attribute__((ext_vector_type(16)));
typedef unsigned u32x2 __attribute__((ext_vector_type(2)));
typedef unsigned u32x4 __attribute__((ext_vector_type(4)));

#ifndef MK_N_LAUNCHES
#define MK_N_LAUNCHES 1
#endif

constexpr int D = 1024, BATCH = 4, SEQ = 4096, M = BATCH * SEQ, DEPTH = 2;
constexpr int NPROJ = 2188, NPP = 2304;
constexpr int PC_QA = 0, PC_KVA = 256, PC_QB = 640, PC_KB = 896, PC_VB = 1152, PC_QC = 1408, PC_KC = 1920, PC_VC = 2048, PC_GA = 2176;
constexpr int FF = 2816, FE = 3584, NE = 8, PLE = 256;
constexpr int NCAP = 136 * 256;
constexpr float LN_EPS = 1e-5f;
constexpr float DN_ALPHA = 1.4142135623730951f;
constexpr float LOG2E = 1.4426950408889634f;
constexpr float NEGBIG = -1e30f;

constexpr size_t MiB = 1u << 20;
constexpr size_t WS_CTL = 0, CTL_ZERO_BYTES = 1 * MiB;
constexpr size_t WS_TAB = 1 * MiB;
constexpr size_t WS_MOE_GU = 2 * MiB;
constexpr size_t WS_MOE_D = 114 * MiB;
constexpr size_t WS_PLEG1 = 170 * MiB, WS_PLEP1 = 172 * MiB;
constexpr size_t WS_WIN1 = 173 * MiB, WS_WOUT1 = 178 * MiB, WS_CW1_1 = 180 * MiB;
constexpr size_t WS_R = 181 * MiB;
constexpr size_t WS_WIN0 = 181 * MiB, WS_WOUT0 = 186 * MiB, WS_FGU = 188 * MiB, WS_FD = 199 * MiB, WS_PLEG0 = 205 * MiB, WS_PLEP0 = 207 * MiB;
constexpr size_t WS_Y = 208 * MiB;
constexpr size_t WS_XB = 272 * MiB;
constexpr size_t WS_BIG = 304 * MiB;
constexpr size_t WS_PROJ = WS_BIG;
constexpr size_t WS_AO = WS_BIG + 72 * MiB;
constexpr size_t WS_KCV = WS_BIG + 104 * MiB;
constexpr size_t WS_CW1_0 = WS_BIG + 106 * MiB;
constexpr size_t WS_H = WS_BIG;
constexpr size_t WS_PB = 488 * MiB;
constexpr size_t WS_U = WS_BIG + 8 * MiB;
constexpr size_t WS_HM = WS_R;
constexpr size_t WS_XS = 420 * MiB;
constexpr size_t WS_END = 496 * MiB;
constexpr size_t TB_CBIAS = 0;
constexpr size_t TB_CW2 = 8192;
constexpr size_t TB_ROUTE = 128 * 1024;
constexpr size_t TB_HIST = TB_ROUTE + (size_t)M * 32;
constexpr size_t TB_META = TB_HIST + 256 * 8 * 4;
static_assert(TB_META + 1024 <= 1 * MiB, "tables");
static_assert(WS_HM + (size_t)NCAP * FE * 2 <= WS_XS && WS_XS + (size_t)NCAP * D * 2 <= WS_PB, "moe map");

constexpr int CW_TMO = 0, CW_CODE = 1, CW_BAR = 4096;

constexpr int RING_BYTES = 131072;
constexpr int LDSCTL_OFF = RING_BYTES, MISC_OFF = LDSCTL_OFF + 320;
constexpr int LDS_BYTES = 147456;
constexpr int NWAVES = 8, NTHREADS = 512, GRID = 256;

#define RLX_AGENT __ATOMIC_RELAXED, __HIP_MEMORY_SCOPE_AGENT
#define LDS_WAIT() asm volatile("s_waitcnt lgkmcnt(0)" ::: "memory")
#define VM_WAIT() asm volatile("s_waitcnt vmcnt(0)" ::: "memory")
__device__ __forceinline__ unsigned f2bf(float f) { unsigned u = __builtin_bit_cast(unsigned, f); return (u + 0x7fffu + ((u >> 16) & 1u)) >> 16; }
__device__ __forceinline__ unsigned pk2(float lo, float hi) { return f2bf(lo) | (f2bf(hi) << 16); }
__device__ __forceinline__ float bf2f(unsigned short b) { return __builtin_bit_cast(float, (unsigned)b << 16); }
__device__ __forceinline__ unsigned cvt_pk_bf16(float lo, float hi) { unsigned r; asm volatile("v_cvt_pk_bf16_f32 %0, %1, %2" : "=v"(r) : "v"(lo), "v"(hi)); return r; }
__device__ __forceinline__ float fexp2(float x) { return __builtin_amdgcn_exp2f(x); }
__device__ __forceinline__ float frcp(float x) { return __builtin_amdgcn_rcpf(x); }
__device__ __forceinline__ float sigmoidf_(float x) { return frcp(1.0f + fexp2(-x * LOG2E)); }
__device__ __forceinline__ float wave_sum(float v) {
#pragma unroll
    for (int o = 1; o < 64; o <<= 1) v += __shfl_xor(v, o);
    return v;
}

namespace pg8 {
constexpr int BM = 256, BK = 64, HALF = 128, HTB = HALF * BK * 2, STAGE_BYTES = 8 * HTB, NXCD = 8, WGM = 8;
__host__ __device__ __forceinline__ int lds_byte(int r, int c) { const int st = (r >> 4) * 2 + (c >> 5), rr = r & 15, cc = c & 31, ob = rr * 64 + cc * 2; return st * 1024 + (ob ^ (((ob >> 9) & 1) << 5)); }
__host__ __device__ __forceinline__ void stage_rc(int b, int& R, int& C) { const int st = b / 1024, sb = b % 1024, swz = sb ^ (((sb >> 9) & 1) << 5); R = (st >> 1) * 16 + swz / 64; C = (st & 1) * 32 + (swz % 64) / 2; }
__host__ __device__ __forceinline__ int perm32(int rho) { const int n = rho >> 4, i = rho & 15; return 8 * (i >> 2) + 4 * n + (i & 3); }

struct Unit { int pm, pn, pb; };
struct Gemm { const bf16_t* A; const bf16_t* Bt; int lda; int K; };

struct StaticOrder {
    int nM, nN, nwg, G, c;
    __device__ void init(int nM_, int nN_, int G_, int c_) { nM = nM_; nN = nN_; nwg = nM * nN; G = G_; c = c_; }
    __device__ bool next(int i, Unit& u) const {
        const long L = (long)i * G + c; if (L >= nwg) return false;
        int wgid = (int)L; { const int q = nwg / NXCD, r = nwg % NXCD, xcd = wgid % NXCD, off = wgid / NXCD; wgid = (xcd < r ? xcd * (q + 1) : r * (q + 1) + (xcd - r) * q) + off; }
        const int nig = WGM * nN, gid = wgid / nig, fm = gid * WGM, gsz = (nM - fm) < WGM ? (nM - fm) : WGM;
        u.pm = fm + ((wgid % nig) % gsz); u.pn = (wgid % nig) / gsz; u.pb = u.pn; return true;
    }
};
struct MoeOrder {
    StaticOrder so; const int* tile_e;
    __device__ bool next(int i, Unit& u) const {
        if (!so.next(i, u)) return false;
        u.pb = __builtin_amdgcn_readfirstlane(tile_e[u.pm]) * so.nN + u.pn; return true;
    }
};

template <int MODE> struct EpiBf16 {
    static constexpr bool PERM = true;
    bf16_t* O; int ldc;
    __device__ __forceinline__ void operator()(const f32x4 (&acc)[2][2][4][2], const Unit& u, int wr, int wc, int fr, int fq) const {
        const int row0 = u.pm * BM + wr * 64 + fr;
        if (MODE == 0) {
            const int col0 = u.pn * BM + wc * 32 + 8 * fq;
#pragma unroll
            for (int ai = 0; ai < 2; ++ai)
#pragma unroll
                for (int m = 0; m < 4; ++m) { bf16_t* rowp = O + (size_t)(row0 + ai * HALF + m * 16) * ldc + col0;
#pragma unroll
                    for (int bj = 0; bj < 2; ++bj) { const f32x4 v0 = acc[ai][bj][m][0], v1 = acc[ai][bj][m][1];
                        u32x4 w; w.x = cvt_pk_bf16(v0[0], v0[1]); w.y = cvt_pk_bf16(v0[2], v0[3]); w.z = cvt_pk_bf16(v1[0], v1[1]); w.w = cvt_pk_bf16(v1[2], v1[3]);
                        *(u32x4*)(rowp + bj * HALF) = w; } }
        } else {
            const int col0 = u.pn * HALF + wc * 32 + 8 * fq;
#pragma unroll
            for (int ai = 0; ai < 2; ++ai)
#pragma unroll
                for (int m = 0; m < 4; ++m) { bf16_t* rowp = O + (size_t)(row0 + ai * HALF + m * 16) * ldc + col0;
                    u32x4 w;
#pragma unroll
                    for (int n = 0; n < 2; ++n) { const f32x4 g = acc[ai][0][m][n], up = acc[ai][1][m][n]; float h0, h1, h2, h3;
                        h0 = g[0] * up[0] * frcp(1.0f + fexp2(-g[0] * LOG2E)); h1 = g[1] * up[1] * frcp(1.0f + fexp2(-g[1] * LOG2E));
                        h2 = g[2] * up[2] * frcp(1.0f + fexp2(-g[2] * LOG2E)); h3 = g[3] * up[3] * frcp(1.0f + fexp2(-g[3] * LOG2E));
                        if (n == 0) { w.x = cvt_pk_bf16(h0, h1); w.y = cvt_pk_bf16(h2, h3); } else { w.z = cvt_pk_bf16(h0, h1); w.w = cvt_pk_bf16(h2, h3); } }
                    asm volatile("" ::: "memory");
                    *(u32x4*)rowp = w; }
        }
    }
};
template <int MODE> struct EpiResid {
    static constexpr bool PERM = false;
    const float* base; float* out; const bf16_t* U; int ldc;
    __device__ __forceinline__ void operator()(const f32x4 (&acc)[2][2][4][2], const Unit& u, int wr, int wc, int fr, int fq) const {
        const int col0 = u.pn * BM + wc * 32 + 4 * fq;
#pragma unroll
        for (int ai = 0; ai < 2; ++ai)
#pragma unroll
            for (int m = 0; m < 4; ++m) { const size_t off = (size_t)(u.pm * BM + ai * HALF + wr * 64 + m * 16 + fr) * ldc + col0;
#pragma unroll
                for (int bj = 0; bj < 2; ++bj)
#pragma unroll
                    for (int n = 0; n < 2; ++n) { const size_t o2 = off + bj * HALF + n * 16; const f32x4 bs = *(const f32x4*)(base + o2); f32x4 a = acc[ai][bj][m][n];
                        if (MODE == 1) { const u32x2 uu = *(const u32x2*)(U + o2);
                            a[0] = sigmoidf_(a[0]) * __builtin_bit_cast(float, uu.x << 16); a[1] = sigmoidf_(a[1]) * __builtin_bit_cast(float, uu.x & 0xffff0000u);
                            a[2] = sigmoidf_(a[2]) * __builtin_bit_cast(float, uu.y << 16); a[3] = sigmoidf_(a[3]) * __builtin_bit_cast(float, uu.y & 0xffff0000u); }
                        *(f32x4*)(out + o2) = bs * DN_ALPHA + a; }
                asm volatile("" ::: "memory"); }
    }
};

#ifndef PG8_SP2
#define PG8_SP2 true
#endif
template <class Epi, class Sched, bool ALIGN_EPI = true, bool SP2 = PG8_SP2>
__device__ __forceinline__ void gemm_phase(LAS unsigned char* lds, const Gemm g, const Sched& S, const Epi& E, int wid_) {
    int z_ = 0; asm volatile("" : "+v"(z_));
    const int lane = (int)__builtin_amdgcn_mbcnt_hi(~0u, __builtin_amdgcn_mbcnt_lo(~0u, (unsigned)z_)), wid = wid_, tid = wid * 64 + lane, wr = wid >> 2, wc = wid & 3, fr = lane & 15, fq = lane >> 4;
    const int K = g.K, nt = K / BK;
    unsigned voffA[2], voffB[2];
#pragma unroll
    for (int i = 0; i < 2; ++i) { int R, C; stage_rc(tid * 16 + i * 8192, R, C); const int Rb = Epi::PERM ? ((R & ~31) + perm32(R & 31)) : R;
        voffA[i] = (unsigned)(R * g.lda + C) * 2u; voffB[i] = (unsigned)(Rb * K + C) * 2u; }
    const size_t kstep = (size_t)(BK * 2);
    const size_t hstepA = (size_t)HALF * g.lda * 2, tstepA = 2 * hstepA;
    const size_t hstepB = (size_t)HALF * K * 2, tstepB = 2 * hstepB;
    const unsigned ldsw = (unsigned)wid * 1024u;
    const int aoff = lds_byte(wr * 64 + fr, fq * 8), boff = lds_byte(wc * 32 + fr, fq * 8);
#define PG8_SA(b, h) (((b) * 2 + (h)) * HTB)
#define PG8_SB(b, h) ((4 + (b) * 2 + (h)) * HTB)
#define PG8_STAGE(bufoff, gbase, voff) do { _Pragma("unroll") for (int _i = 0; _i < 2; ++_i) \
        __builtin_amdgcn_global_load_lds((const unsigned*)((const char*)(gbase) + (voff)[_i]), (LAS unsigned*)(lds + (bufoff) + ldsw + _i * 8192), 16, 0, 0); } while (0)
#define PG8_LDA(dst, b, h) do { _Pragma("unroll") for (int m = 0; m < 4; ++m) _Pragma("unroll") for (int k = 0; k < 2; ++k) dst[m][k] = *(const LAS bf16x8*)(lds + PG8_SA(b, h) + aoff + m * 2048 + k * 1024); } while (0)
#define PG8_LDB(dst, b, h) do { _Pragma("unroll") for (int n = 0; n < 2; ++n) _Pragma("unroll") for (int k = 0; k < 2; ++k) dst[n][k] = *(const LAS bf16x8*)(lds + PG8_SB(b, h) + boff + n * 2048 + k * 1024); } while (0)
#define PG8_MMA(ai, bj, At, Bt) do { __builtin_amdgcn_s_setprio(1); _Pragma("unroll") for (int m = 0; m < 4; ++m) _Pragma("unroll") for (int n = 0; n < 2; ++n) _Pragma("unroll") for (int k = 0; k < 2; ++k) \
        acc[ai][bj][m][n] = __builtin_amdgcn_mfma_f32_16x16x32_bf16(Bt[n][k], At[m][k], acc[ai][bj][m][n], 0, 0, 0); __builtin_amdgcn_s_setprio(0); } while (0)
#define PG8_WAIT_V(n) asm volatile("s_waitcnt vmcnt(" #n ")" ::: "memory")
#define PG8_WAIT_L(n) asm volatile("s_waitcnt lgkmcnt(" #n ")" ::: "memory")
#define PG8_BAR __builtin_amdgcn_s_barrier()
#define PG8_SCHED __builtin_amdgcn_sched_barrier(0)
    Unit cur, nxt; int ui = 0;
    if (!S.next(0, cur)) return;
    f32x4 acc[2][2][4][2];
    { float zf = 0.f; asm volatile("" : "+v"(zf));
#pragma unroll
    for (int a = 0; a < 2; ++a)
#pragma unroll
        for (int b = 0; b < 2; ++b)
#pragma unroll
            for (int m = 0; m < 4; ++m)
#pragma unroll
                for (int n = 0; n < 2; ++n) acc[a][b][m][n] = (f32x4){zf, zf, zf, zf}; }
    bf16x8 At[4][2], B0[2][2], B1[2][2];
    const char* cA = (const char*)g.A + (size_t)cur.pm * tstepA; const char* cB = (const char*)g.Bt + (size_t)cur.pb * tstepB;
    if constexpr (SP2) {
        PG8_STAGE(PG8_SB(0, 0), cB, voffB); PG8_STAGE(PG8_SB(0, 1), cB + hstepB, voffB); PG8_STAGE(PG8_SA(0, 0), cA, voffA); PG8_STAGE(PG8_SA(0, 1), cA + hstepA, voffA);
        if (wr == 1) PG8_BAR;
        PG8_WAIT_V(2); PG8_BAR;
        PG8_STAGE(PG8_SB(1, 0), cB + kstep, voffB); PG8_STAGE(PG8_SA(1, 0), cA + kstep, voffA); PG8_STAGE(PG8_SB(1, 1), cB + hstepB + kstep, voffB);
        PG8_WAIT_V(6); PG8_BAR;
    } else {
        PG8_STAGE(PG8_SB(0, 0), cB, voffB); PG8_STAGE(PG8_SA(0, 0), cA, voffA); PG8_STAGE(PG8_SB(0, 1), cB + hstepB, voffB); PG8_STAGE(PG8_SA(0, 1), cA + hstepA, voffA);
        if (wr == 1) PG8_BAR;
        PG8_WAIT_V(4); PG8_BAR;
        PG8_STAGE(PG8_SB(1, 0), cB + kstep, voffB); PG8_STAGE(PG8_SA(1, 0), cA + kstep, voffA); PG8_STAGE(PG8_SB(1, 1), cB + hstepB + kstep, voffB);
        PG8_WAIT_V(6); PG8_BAR;
    }
    for (;;) {
        const bool has_next = S.next(ui + 1, nxt);
        const char* nA = has_next ? (const char*)g.A + (size_t)nxt.pm * tstepA : cA; const char* nB = has_next ? (const char*)g.Bt + (size_t)nxt.pb * tstepB : cB;
#pragma nounroll
        for (int t = 0; t < nt; t += 2) {
            const bool last = (t == nt - 2);
            const char* a1 = cA + (size_t)(t + 1) * kstep;
            const char* a2 = last ? nA : cA + (size_t)(t + 2) * kstep; const char* b2 = last ? nB : cB + (size_t)(t + 2) * kstep;
            const char* a3 = a2 + kstep; const char* b3 = b2 + kstep;
            if constexpr (SP2) {
            PG8_LDB(B0, 0, 0); PG8_LDB(B1, 0, 1); PG8_SCHED; PG8_LDA(At, 0, 0); PG8_STAGE(PG8_SA(1, 1), a1 + hstepA, voffA);
            PG8_WAIT_V(8); PG8_WAIT_L(0); PG8_BAR; PG8_MMA(0, 0, At, B0); PG8_MMA(0, 1, At, B1); PG8_BAR; PG8_SCHED;
            PG8_LDA(At, 0, 1); PG8_STAGE(PG8_SB(0, 0), b2, voffB); PG8_STAGE(PG8_SB(0, 1), b2 + hstepB, voffB); PG8_STAGE(PG8_SA(0, 0), a2, voffA);
            PG8_WAIT_V(8); PG8_WAIT_L(0); PG8_BAR; PG8_MMA(1, 0, At, B0); PG8_MMA(1, 1, At, B1); PG8_BAR; PG8_SCHED;
            PG8_LDB(B0, 1, 0); PG8_LDB(B1, 1, 1); PG8_SCHED; PG8_LDA(At, 1, 0); PG8_STAGE(PG8_SA(0, 1), a2 + hstepA, voffA);
            PG8_WAIT_V(8); PG8_WAIT_L(0); PG8_BAR; PG8_MMA(0, 0, At, B0); PG8_MMA(0, 1, At, B1); PG8_BAR; PG8_SCHED;
            PG8_LDA(At, 1, 1); PG8_STAGE(PG8_SB(1, 0), b3, voffB); PG8_STAGE(PG8_SB(1, 1), b3 + hstepB, voffB); PG8_STAGE(PG8_SA(1, 0), a3, voffA);
            PG8_WAIT_V(8); PG8_WAIT_L(0); PG8_BAR; PG8_MMA(1, 0, At, B0); PG8_MMA(1, 1, At, B1); PG8_BAR; PG8_SCHED;
            } else {
            PG8_LDB(B0, 0, 0); PG8_SCHED; PG8_LDA(At, 0, 0); PG8_STAGE(PG8_SA(1, 1), a1 + hstepA, voffA);
            PG8_WAIT_L(8); PG8_BAR; PG8_WAIT_L(0); PG8_MMA(0, 0, At, B0); PG8_BAR; PG8_SCHED;
            PG8_LDB(B1, 0, 1); PG8_STAGE(PG8_SB(0, 0), b2, voffB);
            PG8_BAR; PG8_WAIT_L(0); PG8_MMA(0, 1, At, B1); PG8_BAR;
            PG8_LDA(At, 0, 1); PG8_STAGE(PG8_SA(0, 0), a2, voffA);
            PG8_BAR; PG8_WAIT_L(0); PG8_MMA(1, 0, At, B0); PG8_BAR; PG8_SCHED;
            PG8_STAGE(PG8_SB(0, 1), b2 + hstepB, voffB);
            PG8_WAIT_V(6); PG8_BAR; PG8_MMA(1, 1, At, B1); PG8_BAR;
            PG8_LDB(B0, 1, 0); PG8_SCHED; PG8_LDA(At, 1, 0); PG8_STAGE(PG8_SA(0, 1), a2 + hstepA, voffA);
            PG8_WAIT_L(8); PG8_BAR; PG8_WAIT_L(0); PG8_MMA(0, 0, At, B0); PG8_BAR; PG8_SCHED;
            PG8_LDB(B1, 1, 1); PG8_STAGE(PG8_SB(1, 0), b3, voffB);
            PG8_BAR; PG8_WAIT_L(0); PG8_MMA(0, 1, At, B1); PG8_BAR;
            PG8_LDA(At, 1, 1); PG8_STAGE(PG8_SA(1, 0), a3, voffA);
            PG8_BAR; PG8_WAIT_L(0); PG8_MMA(1, 0, At, B0); PG8_BAR; PG8_SCHED;
            PG8_STAGE(PG8_SB(1, 1), b3 + hstepB, voffB);
            PG8_WAIT_V(6); PG8_BAR; PG8_MMA(1, 1, At, B1); PG8_BAR;
            }
        }
        if constexpr (ALIGN_EPI) { if (wr == 0) PG8_BAR; }
        E(acc, cur, wr, wc, fr, fq);
        if (!has_next) break;
        { float zf = 0.f; asm volatile("" : "+v"(zf));
#pragma unroll
        for (int a = 0; a < 2; ++a)
#pragma unroll
            for (int b = 0; b < 2; ++b)
#pragma unroll
                for (int m = 0; m < 4; ++m)
#pragma unroll
                    for (int n = 0; n < 2; ++n) acc[a][b][m][n] = (f32x4){zf, zf, zf, zf}; }
        cur = nxt; cA = nA; cB = nB; ++ui;
        if constexpr (ALIGN_EPI) { if (wr == 1) PG8_BAR; }
    }
    PG8_WAIT_V(0);
    if constexpr (!ALIGN_EPI) { if (wr == 0) PG8_BAR; }
    PG8_BAR;
#undef PG8_SA
#undef PG8_SB
#undef PG8_STAGE
#undef PG8_LDA
#undef PG8_LDB
#undef PG8_MMA
#undef PG8_WAIT_V
#undef PG8_WAIT_L
#undef PG8_BAR
#undef PG8_SCHED
}
}

#define XB_TMO      128
#define XB_XCNT(j)  (256  + 64 * (j))
#define XB_XSUB(j)  (1280 + 64 * (j))
#define XB_XGEN(j)  (2304 + 64 * (j))
#define XB_TOP      3328
#define XB_TOPGEN   3392
#define XCD_BAR_WORDS 3456
#define XB_SPIN_CAP (1u << 18)
__device__ __forceinline__ unsigned xb_ld(unsigned* p)              { return __hip_atomic_load(p, __ATOMIC_RELAXED, __HIP_MEMORY_SCOPE_AGENT); }
__device__ __forceinline__ unsigned xb_add(unsigned* p, unsigned v) { return __hip_atomic_fetch_add(p, v, __ATOMIC_RELAXED, __HIP_MEMORY_SCOPE_AGENT); }
__device__ __forceinline__ unsigned xb_xcc_id() { return (unsigned)__builtin_amdgcn_s_getreg((3 << 11) | 20) & 0xFu; }
#define XB_SPIN(cond, bar) do { unsigned _sp = 0; while (cond) { __builtin_amdgcn_s_sleep(1); \
    if ((++_sp & 255u) == 0u) { if (xb_ld(&(bar)[XB_TMO])) break; if (_sp > XB_SPIN_CAP) { atomicAdd(&(bar)[XB_TMO], 1u); break; } } } } while (0)
struct XcdBarrier { unsigned* bar; unsigned x; volatile LAS unsigned* st; };
__device__ __forceinline__ XcdBarrier xcd_barrier_post(unsigned* bar, volatile LAS unsigned* st) {
    XcdBarrier b; b.bar = bar; b.x = xb_xcc_id(); b.st = st;
    if (threadIdx.x == 0) (void)xb_add(&bar[XB_XCNT(b.x)], 1u);
    return b;
}
__device__ __forceinline__ void xcd_barrier_complete(unsigned* bar, unsigned x, unsigned& nloc, unsigned& nx) {
    const unsigned G = gridDim.x * gridDim.y * gridDim.z;
    unsigned sum, cnt, mine, sp = 0u;
    for (;;) {
        sum = 0u; cnt = 0u; mine = 0u;
#pragma unroll
        for (unsigned j = 0; j < 16; ++j) { const unsigned c = xb_ld(&bar[XB_XCNT(j)]); sum += c; cnt += (c > 0u) ? 1u : 0u; mine = (j == x) ? c : mine; }
        if (sum == G) break;
        __builtin_amdgcn_s_sleep(1);
        if ((++sp & 255u) == 0u) { if (xb_ld(&bar[XB_TMO])) break; if (sp > XB_SPIN_CAP) { atomicAdd(&bar[XB_TMO], 1u); break; } }
    }
    nloc = mine > 0u ? mine : 1u; nx = cnt > 0u ? cnt : 1u;
}
__device__ __forceinline__ void xcd_barrier(const XcdBarrier& b, bool leader) {
    asm volatile("s_waitcnt vmcnt(0)" ::: "memory");
    __syncthreads();
    if (leader) {
        unsigned* bar = b.bar;
        __builtin_amdgcn_s_waitcnt(0);
        unsigned nloc = b.st[0], nx = b.st[1];
        if (nloc == 0u) { xcd_barrier_complete(bar, b.x, nloc, nx); b.st[0] = nloc; b.st[1] = nx; }
        const unsigned old = xb_add(&bar[XB_XSUB(b.x)], 1u);
        const unsigned gen = old / nloc;
        if (old + 1u == (gen + 1u) * nloc) {
            __builtin_amdgcn_fence(__ATOMIC_RELEASE, "agent");
            asm volatile("s_waitcnt vmcnt(0)" ::: "memory");
            const unsigned og = xb_add(&bar[XB_TOP], 1u);
            const unsigned tg = og / nx;
            if (og + 1u == (tg + 1u) * nx) xb_add(&bar[XB_TOPGEN], 1u);
            else XB_SPIN(xb_ld(&bar[XB_TOPGEN]) == tg, bar);
            __builtin_amdgcn_fence(__ATOMIC_ACQUIRE, "agent");
            xb_add(&bar[XB_XGEN(b.x)], 1u);
            asm volatile("s_waitcnt vmcnt(0)" ::: "memory");
        } else {
            XB_SPIN(xb_ld(&bar[XB_XGEN(b.x)]) == gen, bar);
            __builtin_amdgcn_fence(__ATOMIC_ACQUIRE, "agent");
            asm volatile("s_waitcnt vmcnt(0)" ::: "memory");
        }
    }
    __syncthreads();
}

struct Frame {
    LAS unsigned char* lds;
    int tid, lane, wave, vcu; static constexpr int G = GRID;
    unsigned char* ws;
    float* out;
};
__device__ __forceinline__ const float* inp(int i) {
    const __attribute__((address_space(4))) char* kp = (const __attribute__((address_space(4))) char*)__builtin_amdgcn_kernarg_segment_ptr();
    asm volatile("" : "+s"(kp));
    return *(const float* const __attribute__((address_space(4)))*)(kp + 8 * i);
}

template <int KIND> __device__ __forceinline__ int tr_dest(int n) {
    if (KIND == 1) return n < 640 ? n : (n < 652 ? PC_GA + (n - 640) : n - 12);
    if (KIND == 2) return (n >> 7) * 256 + (n & 127);
    if (KIND == 3) return (n >> 7) * 256 + 128 + (n & 127);
    return n;
}
template <int KIND> __device__ __forceinline__ float tr_scale(int n) {
    if (KIND == 1) {
        if (n < 256) return 0.125f * LOG2E;
        if (n >= 652 && n < 908) return 0.17677669529663687f * LOG2E;
        if (n >= 1420 && n < 1932) return 0.125f * LOG2E;
    }
    return 1.0f;
}
template <int KIND> __device__ __forceinline__ void tr_item(const float* W, int K, int N, bf16_t* WT, LAS float* scr, int item, int lane) {
    const int nblk = (N + 31) / 32, kb = item / nblk, nb = item % nblk, k0 = 64 * kb, n0 = 32 * nb;
    const int nl = n0 + (lane & 31);
#pragma unroll 8
    for (int i = 0; i < 32; ++i) { const int kk = 2 * i + (lane >> 5); scr[kk * 33 + (lane & 31)] = (nl < N) ? W[(size_t)(k0 + kk) * N + nl] : 0.f; }
    LDS_WAIT(); asm volatile("" ::: "memory");
    const int c = lane & 7;
#pragma unroll
    for (int j = 0; j < 4; ++j) { const int n = (lane >> 3) + 8 * j; const LAS float* s = scr + (8 * c) * 33 + n;
        if (n0 + n < N) { const float sc = tr_scale<KIND>(n0 + n);
            u32x4 o; o.x = pk2(s[0 * 33] * sc, s[1 * 33] * sc); o.y = pk2(s[2 * 33] * sc, s[3 * 33] * sc); o.z = pk2(s[4 * 33] * sc, s[5 * 33] * sc); o.w = pk2(s[6 * 33] * sc, s[7 * 33] * sc);
            *(u32x4*)(WT + (size_t)tr_dest<KIND>(n0 + n) * K + k0 + 8 * c) = o; } }
    LDS_WAIT(); asm volatile("" ::: "memory");
}
__device__ __forceinline__ void cvt_rows(const float* src, bf16_t* dst, size_t n8, size_t g, size_t ng) {
    for (size_t i = g; i < n8; i += ng) { const f32x4 a = *(const f32x4*)(src + i * 8), b = *(const f32x4*)(src + i * 8 + 4);
        u32x4 o; o.x = pk2(a[0], a[1]); o.y = pk2(a[2], a[3]); o.z = pk2(b[0], b[1]); o.w = pk2(b[2], b[3]); *(u32x4*)(dst + i * 8) = o; }
}
__device__ __forceinline__ void p0_prologue(Frame& F) {
    LAS float* scr = (LAS float*)(F.lds + F.wave * 16384);
    const int gw = F.vcu * NWAVES + F.wave, NGW = F.G * NWAVES, lane = F.lane;
    unsigned char* ws = F.ws;
    constexpr int I_WIN = 16 * 69, I_WOUT = 16 * 32, I_FG = 16 * 88, I_FD = 44 * 32, I_PG = 16 * 32, I_PP = 4 * 32, I_C1 = 32 * 4, I_C2 = 2 * 2, I_MG = 16 * 112, I_MD = 56 * 32;
    constexpr int N0 = 2 * I_WIN, N1 = N0 + 2 * I_WOUT, N2 = N1 + 2 * I_FG, N3 = N2 + I_FD, N4 = N3 + 2 * I_PG, N5 = N4 + 2 * I_PP, N6 = N5 + 4 * I_C1, N7 = N6 + 4 * I_C2,
                  N8 = N7 + 16 * I_MG, N9 = N8 + 8 * I_MD;
    for (int it = gw; it < N9; it += NGW) {
        int r = it;
        if (r < N0) { const int l = r / I_WIN; r -= l * I_WIN; tr_item<1>(inp(2) + (size_t)l * D * NPROJ, D, NPROJ, (bf16_t*)(ws + (l ? WS_WIN1 : WS_WIN0)), scr, r, lane); continue; }
        if (r < N1) { r -= N0; const int l = r / I_WOUT; r -= l * I_WOUT; tr_item<0>(inp(9) + (size_t)l * D * D, D, D, (bf16_t*)(ws + (l ? WS_WOUT1 : WS_WOUT0)), scr, r, lane); continue; }
        if (r < N2) { r -= N1; const int l = r / I_FG; r -= l * I_FG; if (l == 0) tr_item<2>(inp(12), D, FF, (bf16_t*)(ws + WS_FGU), scr, r, lane); else tr_item<3>(inp(13), D, FF, (bf16_t*)(ws + WS_FGU), scr, r, lane); continue; }
        if (r < N3) { r -= N2; tr_item<0>(inp(14), FF, D, (bf16_t*)(ws + WS_FD), scr, r, lane); continue; }
        if (r < N4) { r -= N3; const int l = r / I_PG; r -= l * I_PG; tr_item<0>(inp(21) + (size_t)l * D * D, D, D, (bf16_t*)(ws + (l ? WS_PLEG1 : WS_PLEG0)), scr, r, lane); continue; }
        if (r < N5) { r -= N4; const int l = r / I_PP; r -= l * I_PP; tr_item<0>(inp(22) + (size_t)l * PLE * D, PLE, D, (bf16_t*)(ws + (l ? WS_PLEP1 : WS_PLEP0)), scr, r, lane); continue; }
        if (r < N6) { r -= N5; const int q = r / I_C1; r -= q * I_C1;
            tr_item<0>(inp(4) + (size_t)q * 2048 * 128, 2048, 128, (bf16_t*)(ws + ((q >> 1) ? WS_CW1_1 : WS_CW1_0)) + (size_t)(q & 1) * 128 * 2048, scr, r, lane); continue; }
        if (r < N7) { r -= N6; const int q = r / I_C2; r -= q * I_C2;
            tr_item<0>(inp(5) + (size_t)q * 128 * 64, 128, 64, (bf16_t*)(ws + WS_TAB + TB_CW2) + (size_t)q * 64 * 128, scr, r, lane); continue; }
        if (r < N8) { r -= N7; const int q = r / I_MG; r -= q * I_MG; const int e = q >> 1;
            if ((q & 1) == 0) tr_item<2>(inp(16) + (size_t)e * D * FE, D, FE, (bf16_t*)(ws + WS_MOE_GU) + (size_t)e * 2 * FE * D, scr, r, lane);
            else tr_item<3>(inp(17) + (size_t)e * D * FE, D, FE, (bf16_t*)(ws + WS_MOE_GU) + (size_t)e * 2 * FE * D, scr, r, lane); continue; }
        { r -= N8; const int e = r / I_MD; r -= e * I_MD; tr_item<0>(inp(18) + (size_t)e * FE * D, FE, D, (bf16_t*)(ws + WS_MOE_D) + (size_t)e * D * FE, scr, r, lane); }
    }
    { const size_t g = (size_t)blockIdx.x * NTHREADS + F.tid, ng = (size_t)F.G * NTHREADS; const size_t n16 = (size_t)(NPP - NPROJ) * D * 2 / 16;
      for (size_t i = g; i < 2 * n16; i += ng) { const int l = i >= n16; const size_t j = i - (l ? n16 : 0); *(u32x4*)(ws + (l ? WS_WIN1 : WS_WIN0) + (size_t)NPROJ * D * 2 + j * 16) = (u32x4){0u, 0u, 0u, 0u}; }
      cvt_rows(inp(0), (bf16_t*)(ws + WS_XB), (size_t)M * D / 8, g, ng); }
    for (int u = gw; u < 4 * 128; u += NGW) { const int q = u >> 7, n = u & 127; const float* pos = inp(3) + (size_t)q * 2048; const float* w1 = inp(4) + (size_t)q * 2048 * 128 + n;
        float s = 0.f; for (int k = lane; k < 2048; k += 64) s += pos[k] * w1[(size_t)k * 128]; s = wave_sum(s);
        if (lane == 0) ((float*)(ws + WS_TAB + TB_CBIAS))[u] = s; }
}

namespace at {
typedef short v4i16_t __attribute__((ext_vector_type(4)));
__device__ __forceinline__ s16x4 vtr(const LAS char* p) { return __builtin_bit_cast(s16x4, __builtin_amdgcn_ds_read_tr16_b64_v4i16((LAS v4i16_t*)p)); }
__device__ __forceinline__ void glds16(const void* g, LAS void* l) { __builtin_amdgcn_global_load_lds((const unsigned*)g, (LAS unsigned*)l, 16, 0, 0); }
struct Acc { f32x16 o0, o1; float m, l; };
__device__ __forceinline__ void acc_init(Acc& a) {
#pragma unroll
    for (int r = 0; r < 16; ++r) { a.o0[r] = 0.f; a.o1[r] = 0.f; }
    a.m = NEGBIG; a.l = 0.f;
}
template <int NG> __device__ __forceinline__ void dma_kv(const bf16_t* Kp, const bf16_t* Vp, int pitch, int kv0, LAS char* kslot, LAS char* vslot, int gw, int lane) {
#pragma unroll
    for (int pc = gw; pc < 8; pc += NG) {
        glds16(Kp + (size_t)(kv0 + lane) * pitch + pc * 8, kslot + pc * 1024);
        glds16(Vp + (size_t)(kv0 + 16 * (pc & 3) + (lane >> 2)) * pitch + (pc >> 2) * 32 + (lane & 3) * 8, vslot + pc * 1024);
    }
}
template <int D0A, int D0B, int STEP> __device__ __forceinline__ void score_tile(f32x16& p0, f32x16& p1, const LAS char* kslot, const bf16x8* qr, int dq, unsigned W, float slope2, int r32, int hi) {
    asm volatile("" : "+v"(slope2));
    const float fb = -slope2 * (float)dq;
#pragma unroll
    for (int r = 0; r < 16; ++r) { const int off = STEP * ((r & 3) + 8 * (r >> 2)); p0[r] = __builtin_fmaf(slope2, (float)off, fb); p1[r] = __builtin_fmaf(slope2, (float)(off + 32 * STEP), fb); }
    const LAS char* kb = kslot + hi * 1024 + r32 * 16;
#pragma unroll
    for (int d0 = D0A; d0 < D0B; ++d0) {
        const bf16x8 b0 = *(const LAS bf16x8*)(kb + d0 * 2048), b1 = *(const LAS bf16x8*)(kb + d0 * 2048 + 512);
        p0 = __builtin_amdgcn_mfma_f32_32x32x16_bf16(b0, qr[d0], p0, 0, 0, 0);
        p1 = __builtin_amdgcn_mfma_f32_32x32x16_bf16(b1, qr[d0], p1, 0, 0, 0);
    }
#pragma unroll
    for (int r = 0; r < 16; ++r) { const int off = STEP * ((r & 3) + 8 * (r >> 2));
        if ((unsigned)(dq - off) >= W) p0[r] = NEGBIG;
        if ((unsigned)(dq - off - 32 * STEP) >= W) p1[r] = NEGBIG; }
}
__device__ __forceinline__ void softmax_pv(Acc& a, f32x16& p0, f32x16& p1, const LAS char* vlane) {
    float rm = fmaxf(p0[0], p1[0]);
#pragma unroll
    for (int r = 1; r < 16; ++r) rm = fmaxf(rm, fmaxf(p0[r], p1[r]));
    rm = fmaxf(rm, __shfl_xor(rm, 32));
    const float mn = fmaxf(a.m, rm), f = fexp2(a.m - mn);
    a.m = mn;
    float sum = 0.f;
#pragma unroll
    for (int r = 0; r < 16; ++r) { const float e0 = p0[r] > -1e29f ? fexp2(p0[r] - mn) : 0.f, e1 = p1[r] > -1e29f ? fexp2(p1[r] - mn) : 0.f; p0[r] = e0; p1[r] = e1; sum += e0 + e1; }
    a.l = a.l * f + sum;
    if (__any(f != 1.0f)) {
#pragma unroll
        for (int r = 0; r < 16; ++r) { a.o0[r] *= f; a.o1[r] *= f; } }
    u32x4 w0, w1, w2, w3;
    w0.x = cvt_pk_bf16(p0[0], p0[1]); w0.y = cvt_pk_bf16(p0[2], p0[3]); w0.z = cvt_pk_bf16(p0[4], p0[5]); w0.w = cvt_pk_bf16(p0[6], p0[7]);
    w1.x = cvt_pk_bf16(p0[8], p0[9]); w1.y = cvt_pk_bf16(p0[10], p0[11]); w1.z = cvt_pk_bf16(p0[12], p0[13]); w1.w = cvt_pk_bf16(p0[14], p0[15]);
    w2.x = cvt_pk_bf16(p1[0], p1[1]); w2.y = cvt_pk_bf16(p1[2], p1[3]); w2.z = cvt_pk_bf16(p1[4], p1[5]); w2.w = cvt_pk_bf16(p1[6], p1[7]);
    w3.x = cvt_pk_bf16(p1[8], p1[9]); w3.y = cvt_pk_bf16(p1[10], p1[11]); w3.z = cvt_pk_bf16(p1[12], p1[13]); w3.w = cvt_pk_bf16(p1[14], p1[15]);
    const bf16x8 pw[4] = {__builtin_bit_cast(bf16x8, w0), __builtin_bit_cast(bf16x8, w1), __builtin_bit_cast(bf16x8, w2), __builtin_bit_cast(bf16x8, w3)};
#pragma unroll
    for (int s = 0; s < 4; ++s) {
        const s16x4 l0 = vtr(vlane + s * 1024), h0 = vtr(vlane + s * 1024 + 512), l1 = vtr(vlane + 4096 + s * 1024), h1 = vtr(vlane + 4096 + s * 1024 + 512);
        const bf16x8 v0 = {l0[0], l0[1], l0[2], l0[3], h0[0], h0[1], h0[2], h0[3]}, v1 = {l1[0], l1[1], l1[2], l1[3], h1[0], h1[1], h1[2], h1[3]};
        a.o0 = __builtin_amdgcn_mfma_f32_32x32x16_bf16(v0, pw[s], a.o0, 0, 0, 0);
        a.o1 = __builtin_amdgcn_mfma_f32_32x32x16_bf16(v1, pw[s], a.o1, 0, 0, 0);
    }
}
__device__ __forceinline__ int vlane_off(int lane) { const int hi = lane >> 5; return ((lane >> 4) & 1) * 32 + (lane & 3) * 8 + (4 * hi + ((lane & 15) >> 2)) * 64; }
__device__ __forceinline__ void load_q(bf16x8* qr, const bf16_t* qrow, int hi) {
#pragma unroll
    for (int d0 = 0; d0 < 4; ++d0) qr[d0] = *(const bf16x8*)(qrow + d0 * 16 + hi * 8);
}
struct RangeIt { int t, end; __device__ __forceinline__ bool next(int& k) { if (t >= end) return false; k = t++; return true; } };
struct BitsIt { unsigned long long U; __device__ __forceinline__ bool next(int& k) { if (!U) return false; k = __builtin_ctzll(U); U &= U - 1ull; return true; } };
struct DqCausal { int t4; __device__ __forceinline__ int operator()(int kvt) const { return t4 - 64 * kvt; } };
struct DqCmp { int t4; __device__ __forceinline__ int operator()(int kvt) const { return t4 - 1024 * kvt; } };
struct DqSel { int t4; unsigned long long mask; __device__ __forceinline__ int operator()(int kvt) const { return ((mask >> kvt) & 1ull) ? t4 - 64 * kvt : -1000000; } };

template <int NMAP, int STEP, int NG, class It, class Dq>
__device__ __forceinline__ void flash_stage(Acc* a, const bf16x8* qr, const bf16_t* Kp, const bf16_t* Vp, int pitch, It it, const Dq dqf, unsigned W, float slope2, LAS char* slots, int gw, int lane_) {
    int lane = lane_; asm volatile("" : "+v"(lane));
    const int r32 = lane & 31, hi = lane >> 5, vlo = vlane_off(lane);
    int cur = 0, nx = 0; bool hc = it.next(cur);
    if (hc) dma_kv<NG>(Kp, Vp, pitch, 64 * cur, slots, slots + 8192, gw, lane);
    int s = 0;
    while (hc) {
        const bool hn = it.next(nx);
        VM_WAIT(); __syncthreads();
        if (hn) dma_kv<NG>(Kp, Vp, pitch, 64 * nx, slots + (s ^ 1) * 16384, slots + (s ^ 1) * 16384 + 8192, gw, lane);
        const LAS char* ks = slots + s * 16384; const LAS char* vl = ks + 8192 + vlo;
        const int dq = dqf(cur);
        f32x16 p0, p1;
        if (NMAP == 1) { score_tile<0, 4, STEP>(p0, p1, ks, qr, dq, W, slope2, r32, hi); softmax_pv(a[0], p0, p1, vl); }
        else { score_tile<0, 2, STEP>(p0, p1, ks, qr, dq, W, slope2, r32, hi); softmax_pv(a[0], p0, p1, vl);
               score_tile<2, 4, STEP>(p0, p1, ks, qr, dq, W, slope2, r32, hi); softmax_pv(a[NMAP - 1], p0, p1, vl); }
        cur = nx; hc = hn; s ^= 1;
    }
    __syncthreads();
}
__device__ __forceinline__ void store_ot(bf16_t* orow, const f32x16& o0, const f32x16& o1, int hi) {
#pragma unroll
    for (int g = 0; g < 4; ++g) {
        u32x2 w; w.x = cvt_pk_bf16(o0[4 * g], o0[4 * g + 1]); w.y = cvt_pk_bf16(o0[4 * g + 2], o0[4 * g + 3]); *(u32x2*)(orow + 8 * g + 4 * hi) = w;
        u32x2 v; v.x = cvt_pk_bf16(o1[4 * g], o1[4 * g + 1]); v.y = cvt_pk_bf16(o1[4 * g + 2], o1[4 * g + 3]); *(u32x2*)(orow + 32 + 8 * g + 4 * hi) = v;
    }
}
}

__device__ __forceinline__ bf16_t* ws_bf(Frame& F, size_t off) { return (bf16_t*)(F.ws + off); }

__device__ __forceinline__ void diff_unit(Frame& F, int layer, int b, int h, int qb, float lam, float post) {
    using namespace at;
    const int w = F.wave, lane = F.lane, half = w >> 2, wq = w & 3, r32 = lane & 31, hi = lane >> 5;
    const int t = qb * 128 + 32 * wq + r32; const size_t row = (size_t)b * SEQ + t;
    const bf16_t* PROJ = ws_bf(F, WS_PROJ);
    bf16x8 qr[4]; load_q(qr, PROJ + row * NPP + PC_QB + h * 64, hi);
    Acc a[2]; acc_init(a[0]); acc_init(a[1]);
    const float slope2 = fexp2(-(float)(5 + h)) * LOG2E;
    const bf16_t* Kp = PROJ + (size_t)b * SEQ * NPP + PC_KB + h * 64; const bf16_t* Vp = PROJ + (size_t)b * SEQ * NPP + PC_VB + h * 64;
    const int n = qb + 1;
    LAS char* slots = (LAS char*)F.lds + half * 32768;
    flash_stage<2, 1, 4>(a, qr, Kp, Vp, NPP, RangeIt{half * n, (half + 1) * n}, DqCausal{t - 4 * hi}, 0x7fffffffu, slope2, slots, wq, lane);
    a[0].l += __shfl_xor(a[0].l, 32); a[1].l += __shfl_xor(a[1].l, 32);
    LAS float* mb = (LAS float*)F.lds + (size_t)wq * (2 * 34 * 64) + lane;
    if (half == 1) {
#pragma unroll
        for (int c = 0; c < 2; ++c) { LAS float* p = mb + c * 34 * 64;
#pragma unroll
            for (int r = 0; r < 16; ++r) { p[r * 64] = a[c].o0[r]; p[(16 + r) * 64] = a[c].o1[r]; }
            p[32 * 64] = a[c].m; p[33 * 64] = a[c].l; }
    }
    LDS_WAIT(); __syncthreads();
    if (half == 0) {
        f32x16 o0, o1;
#pragma unroll
        for (int c = 0; c < 2; ++c) { const LAS float* p = mb + c * 34 * 64;
            const float mb_ = p[32 * 64], lb = p[33 * 64], mt = fmaxf(a[c].m, mb_), fa = fexp2(a[c].m - mt), fbb = fexp2(mb_ - mt);
            const float l = a[c].l * fa + lb * fbb, inv = frcp(l), ca = fa * inv * (c ? -lam : 1.0f), cb = fbb * inv * (c ? -lam : 1.0f);
#pragma unroll
            for (int r = 0; r < 16; ++r) { const float x0 = a[c].o0[r] * ca + p[r * 64] * cb, x1 = a[c].o1[r] * ca + p[(16 + r) * 64] * cb;
                if (c == 0) { o0[r] = x0; o1[r] = x1; } else { o0[r] += x0; o1[r] += x1; } } }
        float ss = 0.f;
#pragma unroll
        for (int r = 0; r < 16; ++r) ss += o0[r] * o0[r] + o1[r] * o1[r];
        ss += __shfl_xor(ss, 32);
        const float rs = __builtin_amdgcn_rsqf(ss * (1.0f / 64.0f) + LN_EPS) * post;
        const float* sub = inp(7) + layer * 64;
#pragma unroll
        for (int g = 0; g < 4; ++g) { const f32x4 s0 = *(const f32x4*)(sub + 8 * g + 4 * hi), s1 = *(const f32x4*)(sub + 32 + 8 * g + 4 * hi);
#pragma unroll
            for (int k = 0; k < 4; ++k) { o0[4 * g + k] *= rs * s0[k]; o1[4 * g + k] *= rs * s1[k]; } }
        store_ot(ws_bf(F, WS_AO) + row * D + 256 + h * 64, o0, o1, hi);
    }
    __syncthreads();
}
__device__ __forceinline__ void swa_unit(Frame& F, int layer, int b, int kvh, int qblk) {
    using namespace at;
    const int w = F.wave, lane = F.lane, r32 = lane & 31, hi = lane >> 5, hd = kvh * 4 + (w >> 1);
    const int t = qblk * 64 + 32 * (w & 1) + r32; const size_t row = (size_t)b * SEQ + t;
    const bf16_t* PROJ = ws_bf(F, WS_PROJ);
    bf16x8 qr[4]; load_q(qr, PROJ + row * NPP + PC_QC + hd * 64, hi);
    Acc a; acc_init(a);
    const float slope2 = fexp2(-0.5f * (float)(hd + 1)) * LOG2E;
    const bf16_t* Kp = PROJ + (size_t)b * SEQ * NPP + PC_KC + kvh * 64; const bf16_t* Vp = PROJ + (size_t)b * SEQ * NPP + PC_VC + kvh * 64;
    flash_stage<1, 1, 8>(&a, qr, Kp, Vp, NPP, RangeIt{qblk >= 2 ? qblk - 2 : 0, qblk + 1}, DqCausal{t - 4 * hi}, 128u, slope2, (LAS char*)F.lds, w, lane);
    const float l = a.l + __shfl_xor(a.l, 32), sink2 = inp(8)[layer * 8 + hd] * LOG2E, mt = fmaxf(a.m, sink2), sc = fexp2(a.m - mt), f = sc * frcp(l * sc + fexp2(sink2 - mt));
#pragma unroll
    for (int r = 0; r < 16; ++r) { a.o0[r] *= f; a.o1[r] *= f; }
    store_ot(ws_bf(F, WS_AO) + row * D + 512 + hd * 64, a.o0, a.o1, hi);
}
__device__ __forceinline__ void compress_unit(Frame& F, int layer, int kv, int b, int grp) {
    const int w = F.wave, lane = F.lane, i0 = 32 * grp, q = layer * 2 + kv;
    const bf16_t* PROJ = ws_bf(F, WS_PROJ);
    const bf16_t* w1t = ws_bf(F, layer ? WS_CW1_1 : WS_CW1_0) + (size_t)kv * 128 * 2048;
    const bf16_t* w2t = (const bf16_t*)(F.ws + WS_TAB + TB_CW2) + (size_t)q * 64 * 128;
    const float* cb = (const float*)(F.ws + WS_TAB + TB_CBIAS) + q * 128;
    LAS bf16_t* H1 = (LAS bf16_t*)F.lds;
    f32x4 acc0 = {0.f, 0.f, 0.f, 0.f}, acc1 = acc0;
    const bf16_t* a0 = PROJ + ((size_t)b * SEQ + 16 * (i0 + (lane & 15))) * NPP + PC_KVA + kv * 64 + 8 * (lane >> 4);
    const bf16_t* a1 = a0 + (size_t)256 * NPP;
    const bf16_t* bp = w1t + (size_t)(16 * w + (lane & 15)) * 2048 + 8 * (lane >> 4);
#pragma unroll 4
    for (int kk = 0; kk < 2048; kk += 32) { const size_t ao = (size_t)(kk >> 6) * NPP + (kk & 63);
        const bf16x8 A0 = *(const bf16x8*)(a0 + ao), A1 = *(const bf16x8*)(a1 + ao), B = *(const bf16x8*)(bp + kk);
        acc0 = __builtin_amdgcn_mfma_f32_16x16x32_bf16(A0, B, acc0, 0, 0, 0); acc1 = __builtin_amdgcn_mfma_f32_16x16x32_bf16(A1, B, acc1, 0, 0, 0); }
    { const int n = 16 * w + (lane & 15); const float bias = cb[n];
#pragma unroll
      for (int m = 0; m < 2; ++m)
#pragma unroll
        for (int r = 0; r < 4; ++r) { const float x = (m ? acc1[r] : acc0[r]) + bias; const float u = 0.7978845608028654f * (x + 0.044715f * x * x * x);
            const float th = 1.0f - 2.0f * frcp(1.0f + fexp2(2.0f * LOG2E * u)); H1[(16 * m + 4 * (lane >> 4) + r) * 136 + n] = (bf16_t)f2bf(0.5f * x * (1.0f + th)); } }
    LDS_WAIT(); __syncthreads();
    { const int mt = w & 1, ntile = w >> 1; f32x4 acc = {0.f, 0.f, 0.f, 0.f};
#pragma unroll
      for (int ks = 0; ks < 4; ++ks) { const bf16x8 A = *(const LAS bf16x8*)(H1 + (16 * mt + (lane & 15)) * 136 + 32 * ks + 8 * (lane >> 4));
          const bf16x8 B = *(const bf16x8*)(w2t + (size_t)(16 * ntile + (lane & 15)) * 128 + 32 * ks + 8 * (lane >> 4));
          acc = __builtin_amdgcn_mfma_f32_16x16x32_bf16(A, B, acc, 0, 0, 0); }
      bf16_t* dst = ws_bf(F, WS_KCV) + (size_t)kv * BATCH * 256 * 64 + (size_t)b * 256 * 64;
#pragma unroll
      for (int r = 0; r < 4; ++r) { const int i = i0 + 16 * mt + 4 * (lane >> 4) + r; dst[(size_t)i * 64 + 16 * ntile + (lane & 15)] = (i == 255) ? (bf16_t)0 : (bf16_t)f2bf(acc[r]); } }
    __syncthreads();
}
__device__ __forceinline__ void nsa_unit(Frame& F, int layer, int b, int qblk) {
    using namespace at;
    int lane = F.lane; asm volatile("" : "+v"(lane));
    const int w = F.wave, r32 = lane & 31, hi = lane >> 5, h = w >> 1, ql = 32 * (w & 1) + r32, q0 = qblk * 64;
    const int t = q0 + ql; const size_t row = (size_t)b * SEQ + t;
    const bf16_t* PROJ = ws_bf(F, WS_PROJ);
    LAS char* slots = (LAS char*)F.lds;
    LAS float* impL = (LAS float*)(F.lds + 32768);
    LAS unsigned long long* selm = (LAS unsigned long long*)(F.lds + 32768 + 4 * 64 * 65 * 4);
    bf16x8 qr[4]; load_q(qr, PROJ + row * NPP + PC_QA + h * 64, hi);
    const float slope2 = fexp2(-0.5f * (float)(9 + 2 * h)) * LOG2E;
#define NSA_GATE(i) sigmoidf_(bf2f(PROJ[row * NPP + PC_GA + h * 3 + (i)]))
    f32x16 out0, out1;
    const bf16_t* KC = ws_bf(F, WS_KCV) + (size_t)b * 256 * 64; const bf16_t* VC = KC + (size_t)BATCH * 256 * 64;
    const int nblk = (q0 / 16 + 3) < 255 ? (q0 / 16 + 3) : 255, ntile = (nblk + 63) >> 6;
    float mfin, inv;
    { Acc a; acc_init(a);
      flash_stage<1, 16, 8>(&a, qr, KC, VC, 64, RangeIt{0, ntile}, DqCmp{t - 31 - 64 * hi}, 0x7fffffffu, slope2, slots, w, lane);
      const float l = a.l + __shfl_xor(a.l, 32); inv = l > 0.f ? frcp(l) : 0.f; mfin = a.m;
      const float c = NSA_GATE(0) * inv;
#pragma unroll
      for (int r = 0; r < 16; ++r) { out0[r] = a.o0[r] * c; out1[r] = a.o1[r] * c; } }
    { float vprev = 0.f; int s = 0; int lane = F.lane; asm volatile("" : "+v"(lane)); const int r32 = lane & 31, hi = lane >> 5, ql = 32 * (w & 1) + r32;
      dma_kv<8>(KC, VC, 64, 0, slots, slots + 8192, w, lane);
      for (int kt = 0; kt < ntile; ++kt) {
          VM_WAIT(); __syncthreads();
          if (kt + 1 < ntile) dma_kv<8>(KC, VC, 64, 64 * (kt + 1), slots + (s ^ 1) * 16384, slots + (s ^ 1) * 16384 + 8192, w, lane);
          f32x16 p0, p1; score_tile<0, 4, 16>(p0, p1, slots + s * 16384, qr, t - 31 - 64 * hi - 1024 * kt, 0x7fffffffu, slope2, r32, hi);
          LAS float* ip = impL + (size_t)(h * 64 + ql) * 65 + 16 * kt + hi;
#pragma unroll
          for (int ph = 0; ph < 2; ++ph)
#pragma unroll
              for (int g = 0; g < 4; ++g) { float x[4];
#pragma unroll
                  for (int k = 0; k < 4; ++k) { const float sv = ph ? p1[4 * g + k] : p0[4 * g + k]; x[k] = sv > -1e29f ? fexp2(sv - mfin) * inv : 0.f; }
                  const float hb = 0.5f * x[3], v = __shfl_xor(hb, 32), add = hi ? v : vprev; vprev = v;
                  ip[8 * ph + 2 * g] = x[0] + x[1] + x[2] + hb + add; }
          s ^= 1; }
      LDS_WAIT(); __syncthreads(); }
    { const int tb = q0 >> 6; int ln = lane; asm volatile("" : "+v"(ln));
#pragma nounroll
      for (int i = 0; i < 8; ++i) { const int qq = 8 * w + i; const LAS float* ib = impL + (size_t)qq * 65 + ln;
          float v = ib[0] + ib[64 * 65] + ib[2 * 64 * 65] + ib[3 * 64 * 65];
          const bool forced = (ln == 0) || (ln == tb) || (ln == tb - 1), future = ln > tb;
          v = forced ? 1e9f : (future ? -1.0f : v);
          int cnt = 0;
#pragma unroll 8
          for (int jj = 0; jj < 64; ++jj) { const float vj = __builtin_bit_cast(float, __builtin_amdgcn_readlane(__builtin_bit_cast(int, v), jj)); cnt += (vj > v || (vj == v && jj < ln)) ? 1 : 0; }
          const unsigned long long mk = __ballot(cnt < 16 && !future);
          if (ln == 0) selm[qq] = mk; }
      LDS_WAIT(); __syncthreads(); }
    const bf16_t* Pb = PROJ + (size_t)b * SEQ * NPP + PC_KVA;
    { int l3 = F.lane; asm volatile("" : "+v"(l3));
      unsigned long long U = selm[l3];
      unsigned lo = (unsigned)U, hiw = (unsigned)(U >> 32);
#pragma unroll
      for (int o = 1; o < 64; o <<= 1) { lo |= __shfl_xor(lo, o); hiw |= __shfl_xor(hiw, o); }
      U = ((unsigned long long)(unsigned)__builtin_amdgcn_readfirstlane(hiw) << 32) | (unsigned)__builtin_amdgcn_readfirstlane(lo);
      const unsigned long long mine = selm[32 * (w & 1) + (l3 & 31)];
      Acc a; acc_init(a);
      flash_stage<1, 1, 8>(&a, qr, Pb + 2 * 64, Pb + 3 * 64, NPP, BitsIt{U}, DqSel{t - 4 * hi, mine}, 0x7fffffffu, slope2, slots, w, lane);
      const float l = a.l + __shfl_xor(a.l, 32), c = NSA_GATE(1) * (l > 0.f ? frcp(l) : 0.f);
#pragma unroll
      for (int r = 0; r < 16; ++r) { out0[r] += a.o0[r] * c; out1[r] += a.o1[r] * c; } }
    { Acc a; acc_init(a);
      flash_stage<1, 1, 8>(&a, qr, Pb + 4 * 64, Pb + 5 * 64, NPP, RangeIt{qblk >= 8 ? qblk - 8 : 0, qblk + 1}, DqCausal{t - 4 * hi}, 512u, slope2, slots, w, lane);
      const float l = a.l + __shfl_xor(a.l, 32), c = NSA_GATE(2) * (l > 0.f ? frcp(l) : 0.f);
#pragma unroll
      for (int r = 0; r < 16; ++r) { out0[r] += a.o0[r] * c; out1[r] += a.o1[r] * c; } }
    { int l4 = F.lane; asm volatile("" : "+v"(l4));
      store_ot(ws_bf(F, WS_AO) + ((size_t)b * SEQ + q0 + 32 * (w & 1) + (l4 & 31)) * D + h * 64, out0, out1, l4 >> 5); }
}

template <int MODE> __device__ __forceinline__ void ln_phase(Frame& F, const float* gam, const float* bet, bool write_xb) {
    const int lane = F.lane, w = F.wave, RPC = M / F.G, cu = blockIdx.x;
    const float* Y = (const float*)(F.ws + WS_Y);
    bf16_t* XB = ws_bf(F, WS_XB);
    LAS float* wrT = (LAS float*)F.lds;
    LAS int* histL = (LAS int*)(F.lds + 32768);
    int* route = (int*)(F.ws + WS_TAB + TB_ROUTE);
    if (MODE == 1) {
        const float* wr = inp(15);
        for (int i = F.tid; i < 8192; i += NTHREADS) wrT[(i & 7) * 1024 + (i >> 3)] = wr[i];
        if (F.tid < 8) histL[F.tid] = 0;
        LDS_WAIT(); __syncthreads();
    }
    f32x4 gv[4], bv[4];
#pragma unroll
    for (int j = 0; j < 4; ++j) { gv[j] = *(const f32x4*)(gam + 4 * lane + 256 * j); bv[j] = *(const f32x4*)(bet + 4 * lane + 256 * j); }
    for (int rr = w; rr < RPC; rr += NWAVES) {
        const size_t row = (size_t)cu * RPC + rr;
        f32x4 v[4];
        if (MODE == 2) {
            const int* rt = route + row * 8; const float g1 = __builtin_bit_cast(float, rt[2]), g2 = __builtin_bit_cast(float, rt[3]);
            const bf16_t* y1 = ws_bf(F, WS_XS) + (size_t)rt[4] * D; const bf16_t* y2 = ws_bf(F, WS_XS) + (size_t)rt[5] * D;
#pragma unroll
            for (int j = 0; j < 4; ++j) { const f32x4 x = *(const f32x4*)(F.out + row * D + 4 * lane + 256 * j);
                const u32x2 a = *(const u32x2*)(y1 + 4 * lane + 256 * j), b = *(const u32x2*)(y2 + 4 * lane + 256 * j);
                f32x4 fa = {__builtin_bit_cast(float, a.x << 16), __builtin_bit_cast(float, a.x & 0xffff0000u), __builtin_bit_cast(float, a.y << 16), __builtin_bit_cast(float, a.y & 0xffff0000u)};
                f32x4 fb = {__builtin_bit_cast(float, b.x << 16), __builtin_bit_cast(float, b.x & 0xffff0000u), __builtin_bit_cast(float, b.y << 16), __builtin_bit_cast(float, b.y & 0xffff0000u)};
                v[j] = x * DN_ALPHA + fa * g1 + fb * g2; }
        } else {
#pragma unroll
            for (int j = 0; j < 4; ++j) v[j] = *(const f32x4*)(Y + row * D + 4 * lane + 256 * j);
        }
        float s = 0.f;
#pragma unroll
        for (int j = 0; j < 4; ++j) s += (v[j][0] + v[j][1]) + (v[j][2] + v[j][3]);
        const float mean = wave_sum(s) * (1.0f / D); float s2 = 0.f;
#pragma unroll
        for (int j = 0; j < 4; ++j) { v[j] = v[j] - mean; s2 += (v[j][0] * v[j][0] + v[j][1] * v[j][1]) + (v[j][2] * v[j][2] + v[j][3] * v[j][3]); }
        const float rstd = __builtin_amdgcn_rsqf(wave_sum(s2) * (1.0f / D) + LN_EPS);
#pragma unroll
        for (int j = 0; j < 4; ++j) { v[j] = v[j] * rstd * gv[j] + bv[j]; *(f32x4*)(F.out + row * D + 4 * lane + 256 * j) = v[j]; }
        if (write_xb) {
#pragma unroll
            for (int j = 0; j < 4; ++j) { u32x2 o; o.x = pk2(v[j][0], v[j][1]); o.y = pk2(v[j][2], v[j][3]); *(u32x2*)(XB + row * D + 4 * lane + 256 * j) = o; }
        }
        if (MODE == 1) {
            float lg[8];
#pragma unroll
            for (int e = 0; e < 8; ++e) { float p = 0.f;
#pragma unroll
                for (int j = 0; j < 4; ++j) { const f32x4 ww = *(const LAS f32x4*)(wrT + e * 1024 + 4 * lane + 256 * j); p += (v[j][0] * ww[0] + v[j][1] * ww[1]) + (v[j][2] * ww[2] + v[j][3] * ww[3]); }
                lg[e] = wave_sum(p); }
            int e1 = 0; float l1 = lg[0];
#pragma unroll
            for (int e = 1; e < 8; ++e) if (lg[e] > l1) { l1 = lg[e]; e1 = e; }
            int e2 = -1; float l2 = -3.0e38f;
#pragma unroll
            for (int e = 0; e < 8; ++e) if (e != e1 && lg[e] > l2) { l2 = lg[e]; e2 = e; }
            const float ex = __expf(l2 - l1), g1 = 1.0f / (1.0f + ex), g2 = ex * g1;
            if (lane == 0) { int* rt = route + row * 8; rt[0] = e1; rt[1] = e2; rt[2] = __builtin_bit_cast(int, g1); rt[3] = __builtin_bit_cast(int, g2);
                __hip_atomic_fetch_add(histL + e1, 1, __ATOMIC_RELAXED, __HIP_MEMORY_SCOPE_WORKGROUP); __hip_atomic_fetch_add(histL + e2, 1, __ATOMIC_RELAXED, __HIP_MEMORY_SCOPE_WORKGROUP); }
        }
    }
    if (MODE == 1) { LDS_WAIT(); __syncthreads(); if (F.tid < 8) ((int*)(F.ws + WS_TAB + TB_HIST))[cu * 8 + F.tid] = histL[F.tid]; }
}

__device__ __forceinline__ void moe_dispatch(Frame& F) {
    const int lane = F.lane, w = F.wave, RPC = M / F.G, cu = blockIdx.x;
    LAS int* L = (LAS int*)F.lds;
    const int* hist = (const int*)(F.ws + WS_TAB + TB_HIST);
    int* route = (int*)(F.ws + WS_TAB + TB_ROUTE);
    if (F.tid < 8) { int pre = 0, tot = 0; for (int c = 0; c < F.G; ++c) { const int hc = hist[c * 8 + F.tid]; pre += (c < cu) ? hc : 0; tot += hc; } L[F.tid] = pre; L[8 + F.tid] = tot; }
    LDS_WAIT(); __syncthreads();
    if (F.tid == 0) { int sb = 0; for (int e = 0; e < 8; ++e) { L[16 + e] = sb; sb += ((L[8 + e] + 255) >> 8) << 8; } L[24] = sb;
        if (cu == 0) { int* meta = (int*)(F.ws + WS_TAB + TB_META); for (int e = 0; e < 9; ++e) meta[e] = L[16 + e]; for (int e = 0; e < 8; ++e) meta[16 + e] = L[8 + e];
            for (int e = 0; e < 8; ++e) for (int tl = L[16 + e] >> 8; tl < (L[17 + e] >> 8); ++tl) meta[32 + tl] = e; } }
    LDS_WAIT(); __syncthreads();
    if (w == 0) {
        const size_t tok = (size_t)cu * RPC + lane; int* rt = route + tok * 8; const int e1 = rt[0], e2 = rt[1];
        const unsigned long long lt = (1ull << lane) - 1ull, le = lt | (1ull << lane);
        int pos1 = 0, pos2 = 0;
#pragma unroll
        for (int e = 0; e < 8; ++e) { const unsigned long long m0 = __ballot(e1 == e), m1 = __ballot(e2 == e); const int base = L[16 + e] + L[e];
            if (e1 == e) pos1 = base + __builtin_popcountll(m0 & lt) + __builtin_popcountll(m1 & lt);
            if (e2 == e) pos2 = base + __builtin_popcountll(m0 & le) + __builtin_popcountll(m1 & lt); }
        rt[4] = pos1; rt[5] = pos2; L[32 + 2 * lane] = pos1; L[33 + 2 * lane] = pos2;
    }
    LDS_WAIT(); __syncthreads();
    const bf16_t* XB = ws_bf(F, WS_XB); bf16_t* XS = ws_bf(F, WS_XS);
    for (int a = w; a < 2 * RPC; a += NWAVES) { const size_t tok = (size_t)cu * RPC + (a >> 1); const int pos = L[32 + a];
        const u32x4* s = (const u32x4*)(XB + tok * D); u32x4* d = (u32x4*)(XS + (size_t)pos * D);
        d[lane] = s[lane]; d[64 + lane] = s[64 + lane]; }
}

constexpr int PH_PER_LAYER = 11, N_PHASES = 1 + DEPTH * PH_PER_LAYER;
struct Args { const float* in[25]; float* out; unsigned char* ws; int ph_lo, ph_hi, li, pad; };

__device__ __forceinline__ void run_phase(Frame& F, int ph) {
    using namespace pg8;
#ifndef PHSEL
#define PHSEL 0xFFF
#endif
    if (ph == 0) { int z0 = 0; asm volatile("" : "+v"(z0)); F.lane = (int)__builtin_amdgcn_mbcnt_hi(~0u, __builtin_amdgcn_mbcnt_lo(~0u, (unsigned)z0)); F.tid = F.wave * 64 + F.lane; if (PHSEL & 0x800) p0_prologue(F); return; }
    const int L = (ph - 1) / PH_PER_LAYER, k = (ph - 1) % PH_PER_LAYER;
    const bool moe = (L & 1) != 0;
    int cid = (int)blockIdx.x; asm volatile("" : "+s"(cid));
    { int wv_ = F.wave; asm volatile("" : "+s"(wv_)); F.wave = wv_; }
    { int z_ = 0; asm volatile("" : "+v"(z_)); F.lane = (int)__builtin_amdgcn_mbcnt_hi(~0u, __builtin_amdgcn_mbcnt_lo(~0u, (unsigned)z_)); F.tid = F.wave * 64 + F.lane; }
    { unsigned char* w_ = F.ws; asm volatile("" : "+s"(w_)); F.ws = w_; }
    unsigned char* ws = F.ws;
    switch (k) {
    case 0: if (PHSEL & (1 << 0)) {
        Gemm g{ws_bf(F, WS_XB), ws_bf(F, L ? WS_WIN1 : WS_WIN0), D, D}; StaticOrder S; S.init(M / 256, NPP / 256, F.G, cid);
        EpiBf16<0> E{ws_bf(F, WS_PROJ), NPP};
        gemm_phase(F.lds, g, S, E, F.wave);
    } break;
    case 1: if (PHSEL & (1 << 1)) {
        const float lam_init = 0.8f - 0.6f * __expf(-0.3f * (float)L);
        float lam;
        { const float* dl = inp(6) + L * 128; const int l = F.lane & 31; const float a = dl[l] * dl[32 + l], b = dl[64 + l] * dl[96 + l];
          float sa = (F.lane < 32) ? a : 0.f, sb = (F.lane < 32) ? b : 0.f; sa = wave_sum(sa); sb = wave_sum(sb); lam = __expf(sa) - __expf(sb) + lam_init; }
        for (int u = cid; u < 256; u += F.G) { const int b = u >> 6, h = (u >> 4) & 3, s = u & 15;
            diff_unit(F, L, b, h, 31 - s, lam, 1.0f - lam_init); diff_unit(F, L, b, h, s, lam, 1.0f - lam_init); }
        for (int u = cid; u < 64; u += F.G) compress_unit(F, L, u >> 5, (u >> 3) & 3, u & 7);
        for (int u = cid; u < 512; u += F.G) swa_unit(F, L, u >> 7, (u >> 6) & 1, u & 63);
    } break;
    case 2: if (PHSEL & (1 << 2)) {
        for (int u = cid; u < 256; u += F.G) nsa_unit(F, L, u >> 6, u & 63);
    } break;
    case 3: if (PHSEL & (1 << 3)) {
        Gemm g{ws_bf(F, WS_AO), ws_bf(F, L ? WS_WOUT1 : WS_WOUT0), D, D}; StaticOrder S; S.init(M / 256, D / 256, F.G, cid);
        EpiResid<0> E{L ? F.out : inp(0), (float*)(ws + WS_Y), nullptr, D};
        gemm_phase(F.lds, g, S, E, F.wave);
    } break;
    case 4: if (PHSEL & (1 << 4)) {
        if (moe) ln_phase<1>(F, inp(10) + L * D, inp(11) + L * D, true); else ln_phase<0>(F, inp(10) + L * D, inp(11) + L * D, true);
        cvt_rows(inp(1) + (size_t)L * M * PLE, ws_bf(F, WS_PB), (size_t)M * PLE / 8, (size_t)blockIdx.x * NTHREADS + F.tid, (size_t)F.G * NTHREADS);
    } break;
    case 5: if (PHSEL & (1 << 5)) {
        if (!moe) { Gemm g{ws_bf(F, WS_XB), ws_bf(F, WS_FGU), D, D}; StaticOrder S; S.init(M / 256, 2 * FF / 256, F.G, cid);
            EpiBf16<1> E{ws_bf(F, WS_H), FF}; gemm_phase(F.lds, g, S, E, F.wave); }
        else moe_dispatch(F);
    } break;
    case 6: if (PHSEL & (1 << 6)) {
        if (!moe) { Gemm g{ws_bf(F, WS_H), ws_bf(F, WS_FD), FF, FF}; StaticOrder S; S.init(M / 256, D / 256, F.G, cid);
            EpiResid<0> E{F.out, (float*)(ws + WS_Y), nullptr, D}; gemm_phase(F.lds, g, S, E, F.wave); }
        else { const int* meta = (const int*)(ws + WS_TAB + TB_META);
            MoeOrder S; S.so.init(__builtin_amdgcn_readfirstlane(meta[8]) >> 8, 2 * FE / 256, F.G, cid); S.tile_e = meta + 32;
            Gemm g{ws_bf(F, WS_XS), ws_bf(F, WS_MOE_GU), D, D}; EpiBf16<1> E{ws_bf(F, WS_HM), FE}; gemm_phase(F.lds, g, S, E, F.wave); }
    } break;
    case 7: if (PHSEL & (1 << 7)) {
        if (moe) { const int* meta = (const int*)(ws + WS_TAB + TB_META);
            MoeOrder S; S.so.init(__builtin_amdgcn_readfirstlane(meta[8]) >> 8, D / 256, F.G, cid); S.tile_e = meta + 32;
            Gemm g{ws_bf(F, WS_HM), ws_bf(F, WS_MOE_D), FE, FE}; EpiBf16<0> E{ws_bf(F, WS_XS), D}; gemm_phase(F.lds, g, S, E, F.wave); }
    } break;
    case 8: if (PHSEL & (1 << 8)) {
        if (moe) ln_phase<2>(F, inp(19) + L * D, inp(20) + L * D, true); else ln_phase<0>(F, inp(19) + L * D, inp(20) + L * D, true);
        __syncthreads();
        Gemm g{ws_bf(F, WS_PB), ws_bf(F, L ? WS_PLEP1 : WS_PLEP0), PLE, PLE}; StaticOrder S; S.init(M / 256, D / 256, F.G, cid);
        EpiBf16<0> E{ws_bf(F, WS_U), D}; gemm_phase(F.lds, g, S, E, F.wave);
    } break;
    case 9: if (PHSEL & (1 << 9)) {
        Gemm g{ws_bf(F, WS_XB), ws_bf(F, L ? WS_PLEG1 : WS_PLEG0), D, D}; StaticOrder S; S.init(M / 256, D / 256, F.G, cid);
        EpiResid<1> E{F.out, (float*)(ws + WS_Y), ws_bf(F, WS_U), D}; gemm_phase(F.lds, g, S, E, F.wave);
    } break;
    case 10: if (PHSEL & (1 << 10)) {
        ln_phase<0>(F, inp(23) + L * D, inp(24) + L * D, L + 1 < DEPTH);
    } break;
    default: break;
    }
}
__device__ __forceinline__ bool phase_empty(int ph) { if (ph == 0) return false; const int L = (ph - 1) / PH_PER_LAYER, k = (ph - 1) % PH_PER_LAYER; return k == 7 && (L & 1) == 0; }

__global__ void __launch_bounds__(NTHREADS, 2) mk_fwd(Args args) {
    extern __shared__ __attribute__((aligned(16))) unsigned char lds_raw[];
    Frame F;
    F.lds = (LAS unsigned char*)lds_raw;
    F.tid = threadIdx.x; F.lane = F.tid & 63; F.wave = __builtin_amdgcn_readfirstlane(F.tid >> 6);
    { const int bx = blockIdx.x; F.vcu = (bx % 8) * (GRID / 8) + bx / 8; }
    F.ws = args.ws; F.out = args.out;
    for (int u = F.tid; u < (LDS_BYTES - LDSCTL_OFF) / 4; u += NTHREADS) ((LAS unsigned*)(F.lds + LDSCTL_OFF))[u] = 0u;
    __syncthreads();
    unsigned* ctl = (unsigned*)(F.ws + WS_CTL);
    XcdBarrier bar; bar.bar = ctl + CW_BAR + args.li * XCD_BAR_WORDS; bar.x = 0; bar.st = nullptr;
    const bool multi = (args.ph_hi - args.ph_lo) > 1;
    if (multi) bar = xcd_barrier_post(ctl + CW_BAR + args.li * XCD_BAR_WORDS, (volatile LAS unsigned*)(F.lds + MISC_OFF) + 8);
    bool first = true;
    for (int ph = args.ph_lo; ph < args.ph_hi; ++ph) {
        if (phase_empty(ph)) continue;
        if (!first) { int z_ = 0; asm volatile("" : "+v"(z_)); const int ln = (int)__builtin_amdgcn_mbcnt_hi(~0u, __builtin_amdgcn_mbcnt_lo(~0u, (unsigned)z_)); xcd_barrier(bar, F.wave == 0 && ln == 0); }
        run_phase(F, ph);
        first = false;
    }
}

extern "C" void kernel_launch(void* const* d_in, const int* in_sizes, int n_in, void* d_out, int out_size, void* d_ws, size_t ws_size, hipStream_t stream) {
    static int grid = 0;
    if (grid == 0) {
        if (n_in != 25 || out_size != M * D || ws_size < WS_END) { fprintf(stderr, "kernel_launch: unexpected sizes n_in %d out %d ws %zu (need %zu)\n", n_in, out_size, ws_size, (size_t)WS_END); grid = -1; return; }
        int dev = 0, cus = 0, per_cu = 0;
        if (hipGetDevice(&dev) != hipSuccess || hipDeviceGetAttribute(&cus, hipDeviceAttributeMultiprocessorCount, dev) != hipSuccess) { grid = -1; return; }
        if (hipFuncSetAttribute((const void*)mk_fwd, hipFuncAttributeMaxDynamicSharedMemorySize, LDS_BYTES) != hipSuccess) { fprintf(stderr, "kernel_launch: hipFuncSetAttribute failed\n"); grid = -1; return; }
        if (hipOccupancyMaxActiveBlocksPerMultiprocessor(&per_cu, (const void*)mk_fwd, NTHREADS, LDS_BYTES) != hipSuccess || per_cu < 1) { fprintf(stderr, "kernel_launch: occupancy query says %d blocks per CU\n", per_cu); (void)hipGetLastError(); grid = -1; return; }
        if (cus < 256) { fprintf(stderr, "kernel_launch: needs 256 CUs, device has %d\n", cus); grid = -1; return; }
        grid = 256;
    }
    if (grid < 0) return;
    (void)hipMemsetAsync((char*)d_ws + WS_CTL, 0, CTL_ZERO_BYTES, stream);
    Args a{};
    for (int i = 0; i < 25; ++i) a.in[i] = (const float*)d_in[i];
    a.out = (float*)d_out; a.ws = (unsigned char*)d_ws;
#if MK_N_LAUNCHES == 1
    a.ph_lo = 0; a.ph_hi = N_PHASES; a.li = 0;
    hipLaunchKernelGGL(mk_fwd, dim3(grid), dim3(NTHREADS), LDS_BYTES, stream, a);
#else
    for (int ph = 0; ph < N_PHASES; ++ph) { a.ph_lo = ph; a.ph_hi = ph + 1; a.li = 0;
        hipLaunchKernelGGL(mk_fwd, dim3(grid), dim3(NTHREADS), LDS_BYTES, stream, a); }
#endif
}
```

```cpp
#include <hip/hip_runtime.h>
#include <hip/hip_bf16.h>
#include <cstdint>
#include <cstdio>

#define GAS __attribute__((address_space(1)))
#define LAS __attribute__((address_space(3)))
typedef unsigned short bf16_t;
typedef short bf16x8 __attribute__((ext_vector_type(8)));
typedef short s16x4 __attribute__((ext_vector_type(4)));
typedef float f32x2 __attribute__((ext_vector_type(2)));
typedef float f32x4 __attribute__((ext_vector_type(4)));
typedef float f32x16 __attribute__((ext_vector_type(16)));
typedef unsigned u32x2 __attribute__((ext_vector_type(2)));
typedef unsigned u32x4 __attribute__((ext_vector_type(4)));

#ifndef MK_N_LAUNCHES
#define MK_N_LAUNCHES 1
#endif

constexpr int D = 1024, BATCH = 4, SEQ = 4096, M = BATCH * SEQ, DEPTH = 2;
constexpr int NPROJ = 2188, NPP = 2304;
constexpr int PC_QA = 0, PC_KVA = 256, PC_QB = 640, PC_KB = 896, PC_VB = 1152, PC_QC = 1408, PC_KC = 1920, PC_VC = 2048, PC_GA = 2176;
constexpr int FF = 2816, FE = 3584, NE = 8, PLE = 256;
constexpr int NCAP = 136 * 256;
constexpr float LN_EPS = 1e-5f;
constexpr float DN_ALPHA = 1.4142135623730951f;
constexpr float LOG2E = 1.4426950408889634f;
constexpr float NEGBIG = -1e30f;

constexpr size_t MiB = 1u << 20;
constexpr size_t WS_CTL = 0, CTL_ZERO_BYTES = 1 * MiB;
constexpr size_t WS_TAB = 1 * MiB;
constexpr size_t WS_MOE_GU = 2 * MiB;
constexpr size_t WS_MOE_D = 114 * MiB;
constexpr size_t WS_PLEG1 = 170 * MiB, WS_PLEP1 = 172 * MiB;
constexpr size_t WS_WIN1 = 173 * MiB, WS_WOUT1 = 178 * MiB, WS_CW1_1 = 180 * MiB;
constexpr size_t WS_R = 181 * MiB;
constexpr size_t WS_WIN0 = 181 * MiB, WS_WOUT0 = 186 * MiB, WS_FGU = 188 * MiB, WS_FD = 199 * MiB, WS_PLEG0 = 205 * MiB, WS_PLEP0 = 207 * MiB;
constexpr size_t WS_Y = 208 * MiB;
constexpr size_t WS_XB = 272 * MiB;
constexpr size_t WS_BIG = 304 * MiB;
constexpr size_t WS_PROJ = WS_BIG;
constexpr size_t WS_AO = WS_BIG + 72 * MiB;
constexpr size_t WS_KCV = WS_BIG + 104 * MiB;
constexpr size_t WS_CW1_0 = WS_BIG + 106 * MiB;
constexpr size_t WS_H = WS_BIG;
constexpr size_t WS_PB = 488 * MiB;
constexpr size_t WS_U = WS_BIG + 8 * MiB;
constexpr size_t WS_HM = WS_R;
constexpr size_t WS_XS = 420 * MiB;
constexpr size_t WS_END = 496 * MiB;
constexpr size_t TB_CBIAS = 0;
constexpr size_t TB_CW2 = 8192;
constexpr size_t TB_ROUTE = 128 * 1024;
constexpr size_t TB_HIST = TB_ROUTE + (size_t)M * 32;
constexpr size_t TB_META = TB_HIST + 256 * 8 * 4;
static_assert(TB_META + 1024 <= 1 * MiB, "tables");
static_assert(WS_HM + (size_t)NCAP * FE * 2 <= WS_XS && WS_XS + (size_t)NCAP * D * 2 <= WS_PB, "moe map");

constexpr int CW_TMO = 0, CW_CODE = 1, CW_BAR = 4096;

constexpr int RING_BYTES = 131072;
constexpr int LDSCTL_OFF = RING_BYTES, MISC_OFF = LDSCTL_OFF + 320;
constexpr int LDS_BYTES = 147456;
constexpr int NWAVES = 8, NTHREADS = 512, GRID = 256;

#define RLX_AGENT __ATOMIC_RELAXED, __HIP_MEMORY_SCOPE_AGENT
#define LDS_WAIT() asm volatile("s_waitcnt lgkmcnt(0)" ::: "memory")
#define VM_WAIT() asm volatile("s_waitcnt vmcnt(0)" ::: "memory")
__device__ __forceinline__ unsigned f2bf(float f) { unsigned u = __builtin_bit_cast(unsigned, f); return (u + 0x7fffu + ((u >> 16) & 1u)) >> 16; }
__device__ __forceinline__ unsigned pk2(float lo, float hi) { return f2bf(lo) | (f2bf(hi) << 16); }
__device__ __forceinline__ float bf2f(unsigned short b) { return __builtin_bit_cast(float, (unsigned)b << 16); }
__device__ __forceinline__ unsigned cvt_pk_bf16(float lo, float hi) { unsigned r; asm volatile("v_cvt_pk_bf16_f32 %0, %1, %2" : "=v"(r) : "v"(lo), "v"(hi)); return r; }
__device__ __forceinline__ float fexp2(float x) { return __builtin_amdgcn_exp2f(x); }
__device__ __forceinline__ float frcp(float x) { return __builtin_amdgcn_rcpf(x); }
__device__ __forceinline__ float sigmoidf_(float x) { return frcp(1.0f + fexp2(-x * LOG2E)); }
__device__ __forceinline__ float wave_sum(float v) {
#pragma unroll
    for (int o = 1; o < 64; o <<= 1) v += __shfl_xor(v, o);
    return v;
}

namespace pg8 {
constexpr int BM = 256, BK = 64, HALF = 128, HTB = HALF * BK * 2, STAGE_BYTES = 8 * HTB, NXCD = 8, WGM = 8;
__host__ __device__ __forceinline__ int lds_byte(int r, int c) { const int st = (r >> 4) * 2 + (c >> 5), rr = r & 15, cc = c & 31, ob = rr * 64 + cc * 2; return st * 1024 + (ob ^ (((ob >> 9) & 1) << 5)); }
__host__ __device__ __forceinline__ void stage_rc(int b, int& R, int& C) { const int st = b / 1024, sb = b % 1024, swz = sb ^ (((sb >> 9) & 1) << 5); R = (st >> 1) * 16 + swz / 64; C = (st & 1) * 32 + (swz % 64) / 2; }
__host__ __device__ __forceinline__ int perm32(int rho) { const int n = rho >> 4, i = rho & 15; return 8 * (i >> 2) + 4 * n + (i & 3); }

struct Unit { int pm, pn, pb; };
struct Gemm { const bf16_t* A; const bf16_t* Bt; int lda; int K; };

struct StaticOrder {
    int nM, nN, nwg, G, c;
    __device__ void init(int nM_, int nN_, int G_, int c_) { nM = nM_; nN = nN_; nwg = nM * nN; G = G_; c = c_; }
    __device__ bool next(int i, Unit& u) const {
        const long L = (long)i * G + c; if (L >= nwg) return false;
        int wgid = (int)L; { const int q = nwg / NXCD, r = nwg % NXCD, xcd = wgid % NXCD, off = wgid / NXCD; wgid = (xcd < r ? xcd * (q + 1) : r * (q + 1) + (xcd - r) * q) + off; }
        const int nig = WGM * nN, gid = wgid / nig, fm = gid * WGM, gsz = (nM - fm) < WGM ? (nM - fm) : WGM;
        u.pm = fm + ((wgid % nig) % gsz); u.pn = (wgid % nig) / gsz; u.pb = u.pn; return true;
    }
};
struct MoeOrder {
    StaticOrder so; const int* tile_e;
    __device__ bool next(int i, Unit& u) const {
        if (!so.next(i, u)) return false;
        u.pb = __builtin_amdgcn_readfirstlane(tile_e[u.pm]) * so.nN + u.pn; return true;
    }
};

template <int MODE> struct EpiBf16 {
    static constexpr bool PERM = true;
    bf16_t* O; int ldc;
    __device__ __forceinline__ void operator()(const f32x4 (&acc)[2][2][4][2], const Unit& u, int wr, int wc, int fr, int fq) const {
        const int row0 = u.pm * BM + wr * 64 + fr;
        if (MODE == 0) {
            const int col0 = u.pn * BM + wc * 32 + 8 * fq;
#pragma unroll
            for (int ai = 0; ai < 2; ++ai)
#pragma unroll
                for (int m = 0; m < 4; ++m) { bf16_t* rowp = O + (size_t)(row0 + ai * HALF + m * 16) * ldc + col0;
#pragma unroll
                    for (int bj = 0; bj < 2; ++bj) { const f32x4 v0 = acc[ai][bj][m][0], v1 = acc[ai][bj][m][1];
                        u32x4 w; w.x = cvt_pk_bf16(v0[0], v0[1]); w.y = cvt_pk_bf16(v0[2], v0[3]); w.z = cvt_pk_bf16(v1[0], v1[1]); w.w = cvt_pk_bf16(v1[2], v1[3]);
                        *(u32x4*)(rowp + bj * HALF) = w; } }
        } else {
            const int col0 = u.pn * HALF + wc * 32 + 8 * fq;
#pragma unroll
            for (int ai = 0; ai < 2; ++ai)
#pragma unroll
                for (int m = 0; m < 4; ++m) { bf16_t* rowp = O + (size_t)(row0 + ai * HALF + m * 16) * ldc + col0;
                    u32x4 w;
#pragma unroll
                    for (int n = 0; n < 2; ++n) { const f32x4 g = acc[ai][0][m][n], up = acc[ai][1][m][n]; float h0, h1, h2, h3;
                        h0 = g[0] * up[0] * frcp(1.0f + fexp2(-g[0] * LOG2E)); h1 = g[1] * up[1] * frcp(1.0f + fexp2(-g[1] * LOG2E));
                        h2 = g[2] * up[2] * frcp(1.0f + fexp2(-g[2] * LOG2E)); h3 = g[3] * up[3] * frcp(1.0f + fexp2(-g[3] * LOG2E));
                        if (n == 0) { w.x = cvt_pk_bf16(h0, h1); w.y = cvt_pk_bf16(h2, h3); } else { w.z = cvt_pk_bf16(h0, h1); w.w = cvt_pk_bf16(h2, h3); } }
                    asm volatile("" ::: "memory");
                    *(u32x4*)rowp = w; }
        }
    }
};
template <int MODE> struct EpiResid {
    static constexpr bool PERM = false;
    const float* base; float* out; const bf16_t* U; int ldc;
    __device__ __forceinline__ void operator()(const f32x4 (&acc)[2][2][4][2], const Unit& u, int wr, int wc, int fr, int fq) const {
        const int col0 = u.pn * BM + wc * 32 + 4 * fq;
#pragma unroll
        for (int ai = 0; ai < 2; ++ai)
#pragma unroll
            for (int m = 0; m < 4; ++m) { const size_t off = (size_t)(u.pm * BM + ai * HALF + wr * 64 + m * 16 + fr) * ldc + col0;
#pragma unroll
                for (int bj = 0; bj < 2; ++bj)
#pragma unroll
                    for (int n = 0; n < 2; ++n) { const size_t o2 = off + bj * HALF + n * 16; const f32x4 bs = *(const f32x4*)(base + o2); f32x4 a = acc[ai][bj][m][n];
                        if (MODE == 1) { const u32x2 uu = *(const u32x2*)(U + o2);
                            a[0] = sigmoidf_(a[0]) * __builtin_bit_cast(float, uu.x << 16); a[1] = sigmoidf_(a[1]) * __builtin_bit_cast(float, uu.x & 0xffff0000u);
                            a[2] = sigmoidf_(a[2]) * __builtin_bit_cast(float, uu.y << 16); a[3] = sigmoidf_(a[3]) * __builtin_bit_cast(float, uu.y & 0xffff0000u); }
                        *(f32x4*)(out + o2) = bs * DN_ALPHA + a; }
                asm volatile("" ::: "memory"); }
    }
};

#ifndef PG8_SP2
#define PG8_SP2 true
#endif
template <class Epi, class Sched, bool ALIGN_EPI = true, bool SP2 = PG8_SP2>
__device__ __forceinline__ void gemm_phase(LAS unsigned char* lds, const Gemm g, const Sched& S, const Epi& E, int wid_) {
    int z_ = 0; asm volatile("" : "+v"(z_));
    const int lane = (int)__builtin_amdgcn_mbcnt_hi(~0u, __builtin_amdgcn_mbcnt_lo(~0u, (unsigned)z_)), wid = wid_, tid = wid * 64 + lane, wr = wid >> 2, wc = wid & 3, fr = lane & 15, fq = lane >> 4;
    const int K = g.K, nt = K / BK;
    unsigned voffA[2], voffB[2];
#pragma unroll
    for (int i = 0; i < 2; ++i) { int R, C; stage_rc(tid * 16 + i * 8192, R, C); const int Rb = Epi::PERM ? ((R & ~31) + perm32(R & 31)) : R;
        voffA[i] = (unsigned)(R * g.lda + C) * 2u; voffB[i] = (unsigned)(Rb * K + C) * 2u; }
    const size_t kstep = (size_t)(BK * 2);
    const size_t hstepA = (size_t)HALF * g.lda * 2, tstepA = 2 * hstepA;
    const size_t hstepB = (size_t)HALF * K * 2, tstepB = 2 * hstepB;
    const unsigned ldsw = (unsigned)wid * 1024u;
    const int aoff = lds_byte(wr * 64 + fr, fq * 8), boff = lds_byte(wc * 32 + fr, fq * 8);
#define PG8_SA(b, h) (((b) * 2 + (h)) * HTB)
#define PG8_SB(b, h) ((4 + (b) * 2 + (h)) * HTB)
#define PG8_STAGE(bufoff, gbase, voff) do { _Pragma("unroll") for (int _i = 0; _i < 2; ++_i) \
        __builtin_amdgcn_global_load_lds((const unsigned*)((const char*)(gbase) + (voff)[_i]), (LAS unsigned*)(lds + (bufoff) + ldsw + _i * 8192), 16, 0, 0); } while (0)
#define PG8_LDA(dst, b, h) do { _Pragma("unroll") for (int m = 0; m < 4; ++m) _Pragma("unroll") for (int k = 0; k < 2; ++k) dst[m][k] = *(const LAS bf16x8*)(lds + PG8_SA(b, h) + aoff + m * 2048 + k * 1024); } while (0)
#define PG8_LDB(dst, b, h) do { _Pragma("unroll") for (int n = 0; n < 2; ++n) _Pragma("unroll") for (int k = 0; k < 2; ++k) dst[n][k] = *(const LAS bf16x8*)(lds + PG8_SB(b, h) + boff + n * 2048 + k * 1024); } while (0)
#define PG8_MMA(ai, bj, At, Bt) do { __builtin_amdgcn_s_setprio(1); _Pragma("unroll") for (int m = 0; m < 4; ++m) _Pragma("unroll") for (int n = 0; n < 2; ++n) _Pragma("unroll") for (int k = 0; k < 2; ++k) \
        acc[ai][bj][m][n] = __builtin_amdgcn_mfma_f32_16x16x32_bf16(Bt[n][k], At[m][k], acc[ai][bj][m][n], 0, 0, 0); __builtin_amdgcn_s_setprio(0); } while (0)
#define PG8_WAIT_V(n) asm volatile("s_waitcnt vmcnt(" #n ")" ::: "memory")
#define PG8_WAIT_L(n) asm volatile("s_waitcnt lgkmcnt(" #n ")" ::: "memory")
#define PG8_BAR __builtin_amdgcn_s_barrier()
#define PG8_SCHED __builtin_amdgcn_sched_barrier(0)
    Unit cur, nxt; int ui = 0;
    if (!S.next(0, cur)) return;
    f32x4 acc[2][2][4][2];
    { float zf = 0.f; asm volatile("" : "+v"(zf));
#pragma unroll
    for (int a = 0; a < 2; ++a)
#pragma unroll
        for (int b = 0; b < 2; ++b)
#pragma unroll
            for (int m = 0; m < 4; ++m)
#pragma unroll
                for (int n = 0; n < 2; ++n) acc[a][b][m][n] = (f32x4){zf, zf, zf, zf}; }
    bf16x8 At[4][2], B0[2][2], B1[2][2];
    const char* cA = (const char*)g.A + (size_t)cur.pm * tstepA; const char* cB = (const char*)g.Bt + (size_t)cur.pb * tstepB;
    if constexpr (SP2) {
        PG8_STAGE(PG8_SB(0, 0), cB, voffB); PG8_STAGE(PG8_SB(0, 1), cB + hstepB, voffB); PG8_STAGE(PG8_SA(0, 0), cA, voffA); PG8_STAGE(PG8_SA(0, 1), cA + hstepA, voffA);
        if (wr == 1) PG8_BAR;
        PG8_WAIT_V(2); PG8_BAR;
        PG8_STAGE(PG8_SB(1, 0), cB + kstep, voffB); PG8_STAGE(PG8_SA(1, 0), cA + kstep, voffA); PG8_STAGE(PG8_SB(1, 1), cB + hstepB + kstep, voffB);
        PG8_WAIT_V(6); PG8_BAR;
    } else {
        PG8_STAGE(PG8_SB(0, 0), cB, voffB); PG8_STAGE(PG8_SA(0, 0), cA, voffA); PG8_STAGE(PG8_SB(0, 1), cB + hstepB, voffB); PG8_STAGE(PG8_SA(0, 1), cA + hstepA, voffA);
        if (wr == 1) PG8_BAR;
        PG8_WAIT_V(4); PG8_BAR;
        PG8_STAGE(PG8_SB(1, 0), cB + kstep, voffB); PG8_STAGE(PG8_SA(1, 0), cA + kstep, voffA); PG8_STAGE(PG8_SB(1, 1), cB + hstepB + kstep, voffB);
        PG8_WAIT_V(6); PG8_BAR;
    }
    for (;;) {
        const bool has_next = S.next(ui + 1, nxt);
        const char* nA = has_next ? (const char*)g.A + (size_t)nxt.pm * tstepA : cA; const char* nB = has_next ? (const char*)g.Bt + (size_t)nxt.pb * tstepB : cB;
#pragma nounroll
        for (int t = 0; t < nt; t += 2) {
            const bool last = (t == nt - 2);
            const char* a1 = cA + (size_t)(t + 1) * kstep;
            const char* a2 = last ? nA : cA + (size_t)(t + 2) * kstep; const char* b2 = last ? nB : cB + (size_t)(t + 2) * kstep;
            const char* a3 = a2 + kstep; const char* b3 = b2 + kstep;
            if constexpr (SP2) {
            PG8_LDB(B0, 0, 0); PG8_LDB(B1, 0, 1); PG8_SCHED; PG8_LDA(At, 0, 0); PG8_STAGE(PG8_SA(1, 1), a1 + hstepA, voffA);
            PG8_WAIT_V(8); PG8_WAIT_L(0); PG8_BAR; PG8_MMA(0, 0, At, B0); PG8_MMA(0, 1, At, B1); PG8_BAR; PG8_SCHED;
            PG8_LDA(At, 0, 1); PG8_STAGE(PG8_SB(0, 0), b2, voffB); PG8_STAGE(PG8_SB(0, 1), b2 + hstepB, voffB); PG8_STAGE(PG8_SA(0, 0), a2, voffA);
            PG8_WAIT_V(8); PG8_WAIT_L(0); PG8_BAR; PG8_MMA(1, 0, At, B0); PG8_MMA(1, 1, At, B1); PG8_BAR; PG8_SCHED;
            PG8_LDB(B0, 1, 0); PG8_LDB(B1, 1, 1); PG8_SCHED; PG8_LDA(At, 1, 0); PG8_STAGE(PG8_SA(0, 1), a2 + hstepA, voffA);
            PG8_WAIT_V(8); PG8_WAIT_L(0); PG8_BAR; PG8_MMA(0, 0, At, B0); PG8_MMA(0, 1, At, B1); PG8_BAR; PG8_SCHED;
            PG8_LDA(At, 1, 1); PG8_STAGE(PG8_SB(1, 0), b3, voffB); PG8_STAGE(PG8_SB(1, 1), b3 + hstepB, voffB); PG8_STAGE(PG8_SA(1, 0), a3, voffA);
            PG8_WAIT_V(8); PG8_WAIT_L(0); PG8_BAR; PG8_MMA(1, 0, At, B0); PG8_MMA(1, 1, At, B1); PG8_BAR; PG8_SCHED;
            } else {
            PG8_LDB(B0, 0, 0); PG8_SCHED; PG8_LDA(At, 0, 0); PG8_STAGE(PG8_SA(1, 1), a1 + hstepA, voffA);
            PG8_WAIT_L(8); PG8_BAR; PG8_WAIT_L(0); PG8_MMA(0, 0, At, B0); PG8_BAR; PG8_SCHED;
            PG8_LDB(B1, 0, 1); PG8_STAGE(PG8_SB(0, 0), b2, voffB);
            PG8_BAR; PG8_WAIT_L(0); PG8_MMA(0, 1, At, B1); PG8_BAR;
            PG8_LDA(At, 0, 1); PG8_STAGE(PG8_SA(0, 0), a2, voffA);
            PG8_BAR; PG8_WAIT_L(0); PG8_MMA(1, 0, At, B0); PG8_BAR; PG8_SCHED;
            PG8_STAGE(PG8_SB(0, 1), b2 + hstepB, voffB);
            PG8_WAIT_V(6); PG8_BAR; PG8_MMA(1, 1, At, B1); PG8_BAR;
            PG8_LDB(B0, 1, 0); PG8_SCHED; PG8_LDA(At, 1, 0); PG8_STAGE(PG8_SA(0, 1), a2 + hstepA, voffA);
            PG8_WAIT_L(8); PG8_BAR; PG8_WAIT_L(0); PG8_MMA(0, 0, At, B0); PG8_BAR; PG8_SCHED;
            PG8_LDB(B1, 1, 1); PG8_STAGE(PG8_SB(1, 0), b3, voffB);
            PG8_BAR; PG8_WAIT_L(0); PG8_MMA(0, 1, At, B1); PG8_BAR;
            PG8_LDA(At, 1, 1); PG8_STAGE(PG8_SA(1, 0), a3, voffA);
            PG8_BAR; PG8_WAIT_L(0); PG8_MMA(1, 0, At, B0); PG8_BAR; PG8_SCHED;
            PG8_STAGE(PG8_SB(1, 1), b3 + hstepB, voffB);
            PG8_WAIT_V(6); PG8_BAR; PG8_MMA(1, 1, At, B1); PG8_BAR;
            }
        }
        if constexpr (ALIGN_EPI) { if (wr == 0) PG8_BAR; }
        E(acc, cur, wr, wc, fr, fq);
        if (!has_next) break;
        { float zf = 0.f; asm volatile("" : "+v"(zf));
#pragma unroll
        for (int a = 0; a < 2; ++a)
#pragma unroll
            for (int b = 0; b < 2; ++b)
#pragma unroll
                for (int m = 0; m < 4; ++m)
#pragma unroll
                    for (int n = 0; n < 2; ++n) acc[a][b][m][n] = (f32x4){zf, zf, zf, zf}; }
        cur = nxt; cA = nA; cB = nB; ++ui;
        if constexpr (ALIGN_EPI) { if (wr == 1) PG8_BAR; }
    }
    PG8_WAIT_V(0);
    if constexpr (!ALIGN_EPI) { if (wr == 0) PG8_BAR; }
    PG8_BAR;
#undef PG8_SA
#undef PG8_SB
#undef PG8_STAGE
#undef PG8_LDA
#undef PG8_LDB
#undef PG8_MMA
#undef PG8_WAIT_V
#undef PG8_WAIT_L
#undef PG8_BAR
#undef PG8_SCHED
}
}

#define XB_TMO      128
#define XB_XCNT(j)  (256  + 64 * (j))
#define XB_XSUB(j)  (1280 + 64 * (j))
#define XB_XGEN(j)  (2304 + 64 * (j))
#define XB_TOP      3328
#define XB_TOPGEN   3392
#define XCD_BAR_WORDS 3456
#define XB_SPIN_CAP (1u << 18)
__device__ __forceinline__ unsigned xb_ld(unsigned* p)              { return __hip_atomic_load(p, __ATOMIC_RELAXED, __HIP_MEMORY_SCOPE_AGENT); }
__device__ __forceinline__ unsigned xb_add(unsigned* p, unsigned v) { return __hip_atomic_fetch_add(p, v, __ATOMIC_RELAXED, __HIP_MEMORY_SCOPE_AGENT); }
__device__ __forceinline__ unsigned xb_xcc_id() { return (unsigned)__builtin_amdgcn_s_getreg((3 << 11) | 20) & 0xFu; }
#define XB_SPIN(cond, bar) do { unsigned _sp = 0; while (cond) { __builtin_amdgcn_s_sleep(1); \
    if ((++_sp & 255u) == 0u) { if (xb_ld(&(bar)[XB_TMO])) break; if (_sp > XB_SPIN_CAP) { atomicAdd(&(bar)[XB_TMO], 1u); break; } } } } while (0)
struct XcdBarrier { unsigned* bar; unsigned x; volatile LAS unsigned* st; };
__device__ __forceinline__ XcdBarrier xcd_barrier_post(unsigned* bar, volatile LAS unsigned* st) {
    XcdBarrier b; b.bar = bar; b.x = xb_xcc_id(); b.st = st;
    if (threadIdx.x == 0) (void)xb_add(&bar[XB_XCNT(b.x)], 1u);
    return b;
}
__device__ __forceinline__ void xcd_barrier_complete(unsigned* bar, unsigned x, unsigned& nloc, unsigned& nx) {
    const unsigned G = gridDim.x * gridDim.y * gridDim.z;
    unsigned sum, cnt, mine, sp = 0u;
    for (;;) {
        sum = 0u; cnt = 0u; mine = 0u;
#pragma unroll
        for (unsigned j = 0; j < 16; ++j) { const unsigned c = xb_ld(&bar[XB_XCNT(j)]); sum += c; cnt += (c > 0u) ? 1u : 0u; mine = (j == x) ? c : mine; }
        if (sum == G) break;
        __builtin_amdgcn_s_sleep(1);
        if ((++sp & 255u) == 0u) { if (xb_ld(&bar[XB_TMO])) break; if (sp > XB_SPIN_CAP) { atomicAdd(&bar[XB_TMO], 1u); break; } }
    }
    nloc = mine > 0u ? mine : 1u; nx = cnt > 0u ? cnt : 1u;
}
__device__ __forceinline__ void xcd_barrier(const XcdBarrier& b, bool leader) {
    asm volatile("s_waitcnt vmcnt(0)" ::: "memory");
    __syncthreads();
    if (leader) {
        unsigned* bar = b.bar;
        __builtin_amdgcn_s_waitcnt(0);
        unsigned nloc = b.st[0], nx = b.st[1];
        if (nloc == 0u) { xcd_barrier_complete(bar, b.x, nloc, nx); b.st[0] = nloc; b.st[1] = nx; }
        const unsigned old = xb_add(&bar[XB_XSUB(b.x)], 1u);
        const unsigned gen = old / nloc;
        if (old + 1u == (gen + 1u) * nloc) {
            __builtin_amdgcn_fence(__ATOMIC_RELEASE, "agent");
            asm volatile("s_waitcnt vmcnt(0)" ::: "memory");
            const unsigned og = xb_add(&bar[XB_TOP], 1u);
            const unsigned tg = og / nx;
            if (og + 1u == (tg + 1u) * nx) xb_add(&bar[XB_TOPGEN], 1u);
            else XB_SPIN(xb_ld(&bar[XB_TOPGEN]) == tg, bar);
            __builtin_amdgcn_fence(__ATOMIC_ACQUIRE, "agent");
            xb_add(&bar[XB_XGEN(b.x)], 1u);
            asm volatile("s_waitcnt vmcnt(0)" ::: "memory");
        } else {
            XB_SPIN(xb_ld(&bar[XB_XGEN(b.x)]) == gen, bar);
            __builtin_amdgcn_fence(__ATOMIC_ACQUIRE, "agent");
            asm volatile("s_waitcnt vmcnt(0)" ::: "memory");
        }
    }
    __syncthreads();
}

struct Frame {
    LAS unsigned char* lds;
    int tid, lane, wave, vcu; static constexpr int G = GRID;
    unsigned char* ws;
    float* out;
};
__device__ __forceinline__ const float* inp(int i) {
    const __attribute__((address_space(4))) char* kp = (const __attribute__((address_space(4))) char*)__builtin_amdgcn_kernarg_segment_ptr();
    asm volatile("" : "+s"(kp));
    return *(const float* const __attribute__((address_space(4)))*)(kp + 8 * i);
}

template <int KIND> __device__ __forceinline__ int tr_dest(int n) {
    if (KIND == 1) return n < 640 ? n : (n < 652 ? PC_GA + (n - 640) : n - 12);
    if (KIND == 2) return (n >> 7) * 256 + (n & 127);
    if (KIND == 3) return (n >> 7) * 256 + 128 + (n & 127);
    return n;
}
template <int KIND> __device__ __forceinline__ float tr_scale(int n) {
    if (KIND == 1) {
        if (n < 256) return 0.125f * LOG2E;
        if (n >= 652 && n < 908) return 0.17677669529663687f * LOG2E;
        if (n >= 1420 && n < 1932) return 0.125f * LOG2E;
    }
    return 1.0f;
}
typedef short v4i16_tt __attribute__((ext_vector_type(4)));
template <int KIND> __device__ __forceinline__ void tr_item(const float* W, int K, int N, bf16_t* WT, LAS unsigned char* scr, int item, int lane) {
    constexpr int TP = 136;
    const int nblk = (N + 63) / 64, kb = item / nblk, nb = item % nblk, k0 = 64 * kb, n0 = 64 * nb;
    const int c4 = (lane & 15) * 4, rr = lane >> 4;
    const bool inb = (n0 + c4) < N;
    f32x4 v[16];
#pragma unroll
    for (int i = 0; i < 16; ++i) v[i] = inb ? *(const f32x4*)(W + (size_t)(k0 + 4 * i + rr) * N + n0 + c4) : (f32x4){0.f, 0.f, 0.f, 0.f};
    const float s0 = tr_scale<KIND>(n0 + c4), s1 = tr_scale<KIND>(n0 + c4 + 1), s2 = tr_scale<KIND>(n0 + c4 + 2), s3 = tr_scale<KIND>(n0 + c4 + 3);
#pragma unroll
    for (int i = 0; i < 16; ++i) { u32x2 o; o.x = pk2(v[i][0] * s0, v[i][1] * s1); o.y = pk2(v[i][2] * s2, v[i][3] * s3); *(LAS u32x2*)(scr + (4 * i + rr) * TP + c4 * 2) = o; }
    LDS_WAIT(); asm volatile("" ::: "memory");
    const int g = lane >> 4, i16 = lane & 15;
#pragma unroll
    for (int r = 0; r < 8; ++r) { const int kc = (r & 1) * 4 + g, cbk = r >> 1, n = n0 + 16 * cbk + i16;
        const LAS unsigned char* p = scr + (8 * kc + (i16 >> 2)) * TP + (16 * cbk + 4 * (i16 & 3)) * 2;
        const v4i16_tt lo = __builtin_amdgcn_ds_read_tr16_b64_v4i16((LAS v4i16_tt*)p), hi = __builtin_amdgcn_ds_read_tr16_b64_v4i16((LAS v4i16_tt*)(p + 4 * TP));
        if (n < N) { u32x4 o; const u32x2 a = __builtin_bit_cast(u32x2, lo), b = __builtin_bit_cast(u32x2, hi); o.x = a.x; o.y = a.y; o.z = b.x; o.w = b.y;
            *(u32x4*)(WT + (size_t)tr_dest<KIND>(n) * K + k0 + 8 * kc) = o; } }
    LDS_WAIT(); asm volatile("" ::: "memory");
}
__device__ __forceinline__ void cvt_rows(const float* src, bf16_t* dst, size_t n8, size_t g, size_t ng) {
    for (size_t i = g; i < n8; i += ng) { const f32x4 a = *(const f32x4*)(src + i * 8), b = *(const f32x4*)(src + i * 8 + 4);
        u32x4 o; o.x = pk2(a[0], a[1]); o.y = pk2(a[2], a[3]); o.z = pk2(b[0], b[1]); o.w = pk2(b[2], b[3]); *(u32x4*)(dst + i * 8) = o; }
}
__device__ __forceinline__ void p0_prologue(Frame& F) {
    LAS unsigned char* scr = F.lds + F.wave * 16384;
    const int gw = F.vcu * NWAVES + F.wave, NGW = F.G * NWAVES, lane = F.lane;
    unsigned char* ws = F.ws;
    constexpr int I_WIN = 16 * 35, I_WOUT = 16 * 16, I_FG = 16 * 44, I_FD = 44 * 16, I_PG = 16 * 16, I_PP = 4 * 16, I_C1 = 32 * 2, I_C2 = 2 * 1, I_MG = 16 * 56, I_MD = 56 * 16;
    constexpr int N0 = 2 * I_WIN, N1 = N0 + 2 * I_WOUT, N2 = N1 + 2 * I_FG, N3 = N2 + I_FD, N4 = N3 + 2 * I_PG, N5 = N4 + 2 * I_PP, N6 = N5 + 4 * I_C1, N7 = N6 + 4 * I_C2,
                  N8 = N7 + 16 * I_MG, N9 = N8 + 8 * I_MD;
    for (int it = gw; it < N9; it += NGW) {
        int r = it;
        if (r < N0) { const int l = r / I_WIN; r -= l * I_WIN; tr_item<1>(inp(2) + (size_t)l * D * NPROJ, D, NPROJ, (bf16_t*)(ws + (l ? WS_WIN1 : WS_WIN0)), scr, r, lane); continue; }
        if (r < N1) { r -= N0; const int l = r / I_WOUT; r -= l * I_WOUT; tr_item<0>(inp(9) + (size_t)l * D * D, D, D, (bf16_t*)(ws + (l ? WS_WOUT1 : WS_WOUT0)), scr, r, lane); continue; }
        if (r < N2) { r -= N1; const int l = r / I_FG; r -= l * I_FG; if (l == 0) tr_item<2>(inp(12), D, FF, (bf16_t*)(ws + WS_FGU), scr, r, lane); else tr_item<3>(inp(13), D, FF, (bf16_t*)(ws + WS_FGU), scr, r, lane); continue; }
        if (r < N3) { r -= N2; tr_item<0>(inp(14), FF, D, (bf16_t*)(ws + WS_FD), scr, r, lane); continue; }
        if (r < N4) { r -= N3; const int l = r / I_PG; r -= l * I_PG; tr_item<0>(inp(21) + (size_t)l * D * D, D, D, (bf16_t*)(ws + (l ? WS_PLEG1 : WS_PLEG0)), scr, r, lane); continue; }
        if (r < N5) { r -= N4; const int l = r / I_PP; r -= l * I_PP; tr_item<0>(inp(22) + (size_t)l * PLE * D, PLE, D, (bf16_t*)(ws + (l ? WS_PLEP1 : WS_PLEP0)), scr, r, lane); continue; }
        if (r < N6) { r -= N5; const int q = r / I_C1; r -= q * I_C1;
            tr_item<0>(inp(4) + (size_t)q * 2048 * 128, 2048, 128, (bf16_t*)(ws + ((q >> 1) ? WS_CW1_1 : WS_CW1_0)) + (size_t)(q & 1) * 128 * 2048, scr, r, lane); continue; }
        if (r < N7) { r -= N6; const int q = r / I_C2; r -= q * I_C2;
            tr_item<0>(inp(5) + (size_t)q * 128 * 64, 128, 64, (bf16_t*)(ws + WS_TAB + TB_CW2) + (size_t)q * 64 * 128, scr, r, lane); continue; }
        if (r < N8) { r -= N7; const int q = r / I_MG; r -= q * I_MG; const int e = q >> 1;
            if ((q & 1) == 0) tr_item<2>(inp(16) + (size_t)e * D * FE, D, FE, (bf16_t*)(ws + WS_MOE_GU) + (size_t)e * 2 * FE * D, scr, r, lane);
            else tr_item<3>(inp(17) + (size_t)e * D * FE, D, FE, (bf16_t*)(ws + WS_MOE_GU) + (size_t)e * 2 * FE * D, scr, r, lane); continue; }
        { r -= N8; const int e = r / I_MD; r -= e * I_MD; tr_item<0>(inp(18) + (size_t)e * FE * D, FE, D, (bf16_t*)(ws + WS_MOE_D) + (size_t)e * D * FE, scr, r, lane); }
    }
    { const size_t g = (size_t)blockIdx.x * NTHREADS + F.tid, ng = (size_t)F.G * NTHREADS; const size_t n16 = (size_t)(NPP - NPROJ) * D * 2 / 16;
      for (size_t i = g; i < 2 * n16; i += ng) { const int l = i >= n16; const size_t j = i - (l ? n16 : 0); *(u32x4*)(ws + (l ? WS_WIN1 : WS_WIN0) + (size_t)NPROJ * D * 2 + j * 16) = (u32x4){0u, 0u, 0u, 0u}; }
      cvt_rows(inp(0), (bf16_t*)(ws + WS_XB), (size_t)M * D / 8, g, ng); }
    for (int u = gw; u < 4 * 128; u += NGW) { const int q = u >> 7, n = u & 127; const float* pos = inp(3) + (size_t)q * 2048; const float* w1 = inp(4) + (size_t)q * 2048 * 128 + n;
        float s = 0.f; for (int k = lane; k < 2048; k += 64) s += pos[k] * w1[(size_t)k * 128]; s = wave_sum(s);
        if (lane == 0) ((float*)(ws + WS_TAB + TB_CBIAS))[u] = s; }
}

namespace at {
typedef short v4i16_t __attribute__((ext_vector_type(4)));
__device__ __forceinline__ s16x4 vtr(const LAS char* p) { return __builtin_bit_cast(s16x4, __builtin_amdgcn_ds_read_tr16_b64_v4i16((LAS v4i16_t*)p)); }
__device__ __forceinline__ void glds16(const void* g, LAS void* l) { __builtin_amdgcn_global_load_lds((const unsigned*)g, (LAS unsigned*)l, 16, 0, 0); }
struct Acc { f32x16 o0, o1; float m, l; };
__device__ __forceinline__ void acc_init(Acc& a) {
#pragma unroll
    for (int r = 0; r < 16; ++r) { a.o0[r] = 0.f; a.o1[r] = 0.f; }
    a.m = NEGBIG; a.l = 0.f;
}
template <int NG> __device__ __forceinline__ void dma_kv(const bf16_t* Kp, const bf16_t* Vp, int pitch, int kv0, LAS char* kslot, LAS char* vslot, int gw, int lane) {
#pragma unroll
    for (int pc = gw; pc < 8; pc += NG) {
        glds16(Kp + (size_t)(kv0 + lane) * pitch + pc * 8, kslot + pc * 1024);
        glds16(Vp + (size_t)(kv0 + 16 * (pc & 3) + (lane >> 2)) * pitch + (pc >> 2) * 32 + (lane & 3) * 8, vslot + pc * 1024);
    }
}
template <int D0A, int D0B, int STEP> __device__ __forceinline__ void score_tile(f32x16& p0, f32x16& p1, const LAS char* kslot, const bf16x8* qr, int dq, unsigned W, float slope2, int r32, int hi) {
    asm volatile("" : "+v"(slope2));
    const float fb = -slope2 * (float)dq;
#pragma unroll
    for (int r = 0; r < 16; ++r) { const int off = STEP * ((r & 3) + 8 * (r >> 2)); p0[r] = __builtin_fmaf(slope2, (float)off, fb); p1[r] = __builtin_fmaf(slope2, (float)(off + 32 * STEP), fb); }
    const LAS char* kb = kslot + hi * 1024 + r32 * 16;
#pragma unroll
    for (int d0 = D0A; d0 < D0B; ++d0) {
        const bf16x8 b0 = *(const LAS bf16x8*)(kb + d0 * 2048), b1 = *(const LAS bf16x8*)(kb + d0 * 2048 + 512);
        p0 = __builtin_amdgcn_mfma_f32_32x32x16_bf16(b0, qr[d0], p0, 0, 0, 0);
        p1 = __builtin_amdgcn_mfma_f32_32x32x16_bf16(b1, qr[d0], p1, 0, 0, 0);
    }
#pragma unroll
    for (int r = 0; r < 16; ++r) { const int off = STEP * ((r & 3) + 8 * (r >> 2));
        if ((unsigned)(dq - off) >= W) p0[r] = NEGBIG;
        if ((unsigned)(dq - off - 32 * STEP) >= W) p1[r] = NEGBIG; }
}
__device__ __forceinline__ void softmax_pv(Acc& a, f32x16& p0, f32x16& p1, const LAS char* vlane) {
    float rm = fmaxf(p0[0], p1[0]);
#pragma unroll
    for (int r = 1; r < 16; ++r) rm = fmaxf(rm, fmaxf(p0[r], p1[r]));
    rm = fmaxf(rm, __shfl_xor(rm, 32));
    const float mn = fmaxf(a.m, rm), f = fexp2(a.m - mn);
    a.m = mn;
    float sum = 0.f;
#pragma unroll
    for (int r = 0; r < 16; ++r) { const float e0 = p0[r] > -1e29f ? fexp2(p0[r] - mn) : 0.f, e1 = p1[r] > -1e29f ? fexp2(p1[r] - mn) : 0.f; p0[r] = e0; p1[r] = e1; sum += e0 + e1; }
    a.l = a.l * f + sum;
    if (__any(f != 1.0f)) {
#pragma unroll
        for (int r = 0; r < 16; ++r) { a.o0[r] *= f; a.o1[r] *= f; } }
    u32x4 w0, w1, w2, w3;
    w0.x = cvt_pk_bf16(p0[0], p0[1]); w0.y = cvt_pk_bf16(p0[2], p0[3]); w0.z = cvt_pk_bf16(p0[4], p0[5]); w0.w = cvt_pk_bf16(p0[6], p0[7]);
    w1.x = cvt_pk_bf16(p0[8], p0[9]); w1.y = cvt_pk_bf16(p0[10], p0[11]); w1.z = cvt_pk_bf16(p0[12], p0[13]); w1.w = cvt_pk_bf16(p0[14], p0[15]);
    w2.x = cvt_pk_bf16(p1[0], p1[1]); w2.y = cvt_pk_bf16(p1[2], p1[3]); w2.z = cvt_pk_bf16(p1[4], p1[5]); w2.w = cvt_pk_bf16(p1[6], p1[7]);
    w3.x = cvt_pk_bf16(p1[8], p1[9]); w3.y = cvt_pk_bf16(p1[10], p1[11]); w3.z = cvt_pk_bf16(p1[12], p1[13]); w3.w = cvt_pk_bf16(p1[14], p1[15]);
    const bf16x8 pw[4] = {__builtin_bit_cast(bf16x8, w0), __builtin_bit_cast(bf16x8, w1), __builtin_bit_cast(bf16x8, w2), __builtin_bit_cast(bf16x8, w3)};
#pragma unroll
    for (int s = 0; s < 4; ++s) {
        const s16x4 l0 = vtr(vlane + s * 1024), h0 = vtr(vlane + s * 1024 + 512), l1 = vtr(vlane + 4096 + s * 1024), h1 = vtr(vlane + 4096 + s * 1024 + 512);
        const bf16x8 v0 = {l0[0], l0[1], l0[2], l0[3], h0[0], h0[1], h0[2], h0[3]}, v1 = {l1[0], l1[1], l1[2], l1[3], h1[0], h1[1], h1[2], h1[3]};
        a.o0 = __builtin_amdgcn_mfma_f32_32x32x16_bf16(v0, pw[s], a.o0, 0, 0, 0);
        a.o1 = __builtin_amdgcn_mfma_f32_32x32x16_bf16(v1, pw[s], a.o1, 0, 0, 0);
    }
}
__device__ __forceinline__ int vlane_off(int lane) { const int hi = lane >> 5; return ((lane >> 4) & 1) * 32 + (lane & 3) * 8 + (4 * hi + ((lane & 15) >> 2)) * 64; }
__device__ __forceinline__ void load_q(bf16x8* qr, const bf16_t* qrow, int hi) {
#pragma unroll
    for (int d0 = 0; d0 < 4; ++d0) qr[d0] = *(const bf16x8*)(qrow + d0 * 16 + hi * 8);
}
struct RangeIt { int t, end; __device__ __forceinline__ bool next(int& k) { if (t >= end) return false; k = t++; return true; } };
struct BitsIt { unsigned long long U; __device__ __forceinline__ bool next(int& k) { if (!U) return false; k = __builtin_ctzll(U); U &= U - 1ull; return true; } };
struct DqCausal { int t4; __device__ __forceinline__ int operator()(int kvt) const { return t4 - 64 * kvt; } };
struct DqCmp { int t4; __device__ __forceinline__ int operator()(int kvt) const { return t4 - 1024 * kvt; } };
struct DqSel { int t4; unsigned long long mask; __device__ __forceinline__ int operator()(int kvt) const { return ((mask >> kvt) & 1ull) ? t4 - 64 * kvt : -1000000; } };

template <int NMAP, int STEP, int NG, class It, class Dq>
__device__ __forceinline__ void flash_stage(Acc* a, const bf16x8* qr, const bf16_t* Kp, const bf16_t* Vp, int pitch, It it, const Dq dqf, unsigned W, float slope2, LAS char* slots, int gw, int lane_) {
    int lane = lane_; asm volatile("" : "+v"(lane));
    const int r32 = lane & 31, hi = lane >> 5, vlo = vlane_off(lane);
    int cur = 0, nx = 0; bool hc = it.next(cur);
    if (hc) dma_kv<NG>(Kp, Vp, pitch, 64 * cur, slots, slots + 8192, gw, lane);
    int s = 0;
    while (hc) {
        const bool hn = it.next(nx);
        VM_WAIT(); __syncthreads();
        if (hn) dma_kv<NG>(Kp, Vp, pitch, 64 * nx, slots + (s ^ 1) * 16384, slots + (s ^ 1) * 16384 + 8192, gw, lane);
        const LAS char* ks = slots + s * 16384; const LAS char* vl = ks + 8192 + vlo;
        const int dq = dqf(cur);
        f32x16 p0, p1;
        if (NMAP == 1) { score_tile<0, 4, STEP>(p0, p1, ks, qr, dq, W, slope2, r32, hi); softmax_pv(a[0], p0, p1, vl); }
        else { score_tile<0, 2, STEP>(p0, p1, ks, qr, dq, W, slope2, r32, hi); softmax_pv(a[0], p0, p1, vl);
               score_tile<2, 4, STEP>(p0, p1, ks, qr, dq, W, slope2, r32, hi); softmax_pv(a[NMAP - 1], p0, p1, vl); }
        cur = nx; hc = hn; s ^= 1;
    }
    __syncthreads();
}
__device__ __forceinline__ void store_ot(bf16_t* orow, const f32x16& o0, const f32x16& o1, int hi) {
#pragma unroll
    for (int g = 0; g < 4; ++g) {
        u32x2 w; w.x = cvt_pk_bf16(o0[4 * g], o0[4 * g + 1]); w.y = cvt_pk_bf16(o0[4 * g + 2], o0[4 * g + 3]); *(u32x2*)(orow + 8 * g + 4 * hi) = w;
        u32x2 v; v.x = cvt_pk_bf16(o1[4 * g], o1[4 * g + 1]); v.y = cvt_pk_bf16(o1[4 * g + 2], o1[4 * g + 3]); *(u32x2*)(orow + 32 + 8 * g + 4 * hi) = v;
    }
}
}

__device__ __forceinline__ bf16_t* ws_bf(Frame& F, size_t off) { return (bf16_t*)(F.ws + off); }

__device__ __forceinline__ void diff_unit(Frame& F, int layer, int b, int h, int qb, float lam, float post) {
    using namespace at;
    const int w = F.wave, lane = F.lane, half = w >> 2, wq = w & 3, r32 = lane & 31, hi = lane >> 5;
    const int t = qb * 128 + 32 * wq + r32; const size_t row = (size_t)b * SEQ + t;
    const bf16_t* PROJ = ws_bf(F, WS_PROJ);
    bf16x8 qr[4]; load_q(qr, PROJ + row * NPP + PC_QB + h * 64, hi);
    Acc a[2]; acc_init(a[0]); acc_init(a[1]);
    const float slope2 = fexp2(-(float)(5 + h)) * LOG2E;
    const bf16_t* Kp = PROJ + (size_t)b * SEQ * NPP + PC_KB + h * 64; const bf16_t* Vp = PROJ + (size_t)b * SEQ * NPP + PC_VB + h * 64;
    const int n = qb + 1;
    LAS char* slots = (LAS char*)F.lds + half * 32768;
    flash_stage<2, 1, 4>(a, qr, Kp, Vp, NPP, RangeIt{half * n, (half + 1) * n}, DqCausal{t - 4 * hi}, 0x7fffffffu, slope2, slots, wq, lane);
    a[0].l += __shfl_xor(a[0].l, 32); a[1].l += __shfl_xor(a[1].l, 32);
    LAS float* mb = (LAS float*)F.lds + (size_t)wq * (2 * 34 * 64) + lane;
    if (half == 1) {
#pragma unroll
        for (int c = 0; c < 2; ++c) { LAS float* p = mb + c * 34 * 64;
#pragma unroll
            for (int r = 0; r < 16; ++r) { p[r * 64] = a[c].o0[r]; p[(16 + r) * 64] = a[c].o1[r]; }
            p[32 * 64] = a[c].m; p[33 * 64] = a[c].l; }
    }
    LDS_WAIT(); __syncthreads();
    if (half == 0) {
        f32x16 o0, o1;
#pragma unroll
        for (int c = 0; c < 2; ++c) { const LAS float* p = mb + c * 34 * 64;
            const float mb_ = p[32 * 64], lb = p[33 * 64], mt = fmaxf(a[c].m, mb_), fa = fexp2(a[c].m - mt), fbb = fexp2(mb_ - mt);
            const float l = a[c].l * fa + lb * fbb, inv = frcp(l), ca = fa * inv * (c ? -lam : 1.0f), cb = fbb * inv * (c ? -lam : 1.0f);
#pragma unroll
            for (int r = 0; r < 16; ++r) { const float x0 = a[c].o0[r] * ca + p[r * 64] * cb, x1 = a[c].o1[r] * ca + p[(16 + r) * 64] * cb;
                if (c == 0) { o0[r] = x0; o1[r] = x1; } else { o0[r] += x0; o1[r] += x1; } } }
        float ss = 0.f;
#pragma unroll
        for (int r = 0; r < 16; ++r) ss += o0[r] * o0[r] + o1[r] * o1[r];
        ss += __shfl_xor(ss, 32);
        const float rs = __builtin_amdgcn_rsqf(ss * (1.0f / 64.0f) + LN_EPS) * post;
        const float* sub = inp(7) + layer * 64;
#pragma unroll
        for (int g = 0; g < 4; ++g) { const f32x4 s0 = *(const f32x4*)(sub + 8 * g + 4 * hi), s1 = *(const f32x4*)(sub + 32 + 8 * g + 4 * hi);
#pragma unroll
            for (int k = 0; k < 4; ++k) { o0[4 * g + k] *= rs * s0[k]; o1[4 * g + k] *= rs * s1[k]; } }
        store_ot(ws_bf(F, WS_AO) + row * D + 256 + h * 64, o0, o1, hi);
    }
    __syncthreads();
}
__device__ __forceinline__ void swa_unit(Frame& F, int layer, int b, int kvh, int qblk) {
    using namespace at;
    const int w = F.wave, lane = F.lane, r32 = lane & 31, hi = lane >> 5, hd = kvh * 4 + (w >> 1);
    const int t = qblk * 64 + 32 * (w & 1) + r32; const size_t row = (size_t)b * SEQ + t;
    const bf16_t* PROJ = ws_bf(F, WS_PROJ);
    bf16x8 qr[4]; load_q(qr, PROJ + row * NPP + PC_QC + hd * 64, hi);
    Acc a; acc_init(a);
    const float slope2 = fexp2(-0.5f * (float)(hd + 1)) * LOG2E;
    const bf16_t* Kp = PROJ + (size_t)b * SEQ * NPP + PC_KC + kvh * 64; const bf16_t* Vp = PROJ + (size_t)b * SEQ * NPP + PC_VC + kvh * 64;
    flash_stage<1, 1, 8>(&a, qr, Kp, Vp, NPP, RangeIt{qblk >= 2 ? qblk - 2 : 0, qblk + 1}, DqCausal{t - 4 * hi}, 128u, slope2, (LAS char*)F.lds, w, lane);
    const float l = a.l + __shfl_xor(a.l, 32), sink2 = inp(8)[layer * 8 + hd] * LOG2E, mt = fmaxf(a.m, sink2), sc = fexp2(a.m - mt), f = sc * frcp(l * sc + fexp2(sink2 - mt));
#pragma unroll
    for (int r = 0; r < 16; ++r) { a.o0[r] *= f; a.o1[r] *= f; }
    store_ot(ws_bf(F, WS_AO) + row * D + 512 + hd * 64, a.o0, a.o1, hi);
}
__device__ __forceinline__ void compress_unit(Frame& F, int layer, int kv, int b, int grp) {
    const int w = F.wave, lane = F.lane, i0 = 32 * grp, q = layer * 2 + kv;
    const bf16_t* PROJ = ws_bf(F, WS_PROJ);
    const bf16_t* w1t = ws_bf(F, layer ? WS_CW1_1 : WS_CW1_0) + (size_t)kv * 128 * 2048;
    const bf16_t* w2t = (const bf16_t*)(F.ws + WS_TAB + TB_CW2) + (size_t)q * 64 * 128;
    const float* cb = (const float*)(F.ws + WS_TAB + TB_CBIAS) + q * 128;
    LAS bf16_t* H1 = (LAS bf16_t*)F.lds;
    f32x4 acc0 = {0.f, 0.f, 0.f, 0.f}, acc1 = acc0;
    const bf16_t* a0 = PROJ + ((size_t)b * SEQ + 16 * (i0 + (lane & 15))) * NPP + PC_KVA + kv * 64 + 8 * (lane >> 4);
    const bf16_t* a1 = a0 + (size_t)256 * NPP;
    const bf16_t* bp = w1t + (size_t)(16 * w + (lane & 15)) * 2048 + 8 * (lane >> 4);
#pragma unroll 4
    for (int kk = 0; kk < 2048; kk += 32) { const size_t ao = (size_t)(kk >> 6) * NPP + (kk & 63);
        const bf16x8 A0 = *(const bf16x8*)(a0 + ao), A1 = *(const bf16x8*)(a1 + ao), B = *(const bf16x8*)(bp + kk);
        acc0 = __builtin_amdgcn_mfma_f32_16x16x32_bf16(A0, B, acc0, 0, 0, 0); acc1 = __builtin_amdgcn_mfma_f32_16x16x32_bf16(A1, B, acc1, 0, 0, 0); }
    { const int n = 16 * w + (lane & 15); const float bias = cb[n];
#pragma unroll
      for (int m = 0; m < 2; ++m)
#pragma unroll
        for (int r = 0; r < 4; ++r) { const float x = (m ? acc1[r] : acc0[r]) + bias; const float u = 0.7978845608028654f * (x + 0.044715f * x * x * x);
            const float th = 1.0f - 2.0f * frcp(1.0f + fexp2(2.0f * LOG2E * u)); H1[(16 * m + 4 * (lane >> 4) + r) * 136 + n] = (bf16_t)f2bf(0.5f * x * (1.0f + th)); } }
    LDS_WAIT(); __syncthreads();
    { const int mt = w & 1, ntile = w >> 1; f32x4 acc = {0.f, 0.f, 0.f, 0.f};
#pragma unroll
      for (int ks = 0; ks < 4; ++ks) { const bf16x8 A = *(const LAS bf16x8*)(H1 + (16 * mt + (lane & 15)) * 136 + 32 * ks + 8 * (lane >> 4));
          const bf16x8 B = *(const bf16x8*)(w2t + (size_t)(16 * ntile + (lane & 15)) * 128 + 32 * ks + 8 * (lane >> 4));
          acc = __builtin_amdgcn_mfma_f32_16x16x32_bf16(A, B, acc, 0, 0, 0); }
      bf16_t* dst = ws_bf(F, WS_KCV) + (size_t)kv * BATCH * 256 * 64 + (size_t)b * 256 * 64;
#pragma unroll
      for (int r = 0; r < 4; ++r) { const int i = i0 + 16 * mt + 4 * (lane >> 4) + r; dst[(size_t)i * 64 + 16 * ntile + (lane & 15)] = (i == 255) ? (bf16_t)0 : (bf16_t)f2bf(acc[r]); } }
    __syncthreads();
}
__device__ __forceinline__ void nsa_unit(Frame& F, int layer, int b, int qblk) {
    using namespace at;
    int lane = F.lane; asm volatile("" : "+v"(lane));
    const int w = F.wave, r32 = lane & 31, hi = lane >> 5, h = w >> 1, ql = 32 * (w & 1) + r32, q0 = qblk * 64;
    const int t = q0 + ql; const size_t row = (size_t)b * SEQ + t;
    const bf16_t* PROJ = ws_bf(F, WS_PROJ);
    LAS char* slots = (LAS char*)F.lds;
    LAS float* impL = (LAS float*)(F.lds + 32768);
    LAS unsigned long long* selm = (LAS unsigned long long*)(F.lds + 32768 + 4 * 64 * 65 * 4);
    bf16x8 qr[4]; load_q(qr, PROJ + row * NPP + PC_QA + h * 64, hi);
    const float slope2 = fexp2(-0.5f * (float)(9 + 2 * h)) * LOG2E;
#define NSA_GATE(i) sigmoidf_(bf2f(PROJ[row * NPP + PC_GA + h * 3 + (i)]))
    f32x16 out0, out1;
    const bf16_t* KC = ws_bf(F, WS_KCV) + (size_t)b * 256 * 64; const bf16_t* VC = KC + (size_t)BATCH * 256 * 64;
    const int nblk = (q0 / 16 + 3) < 255 ? (q0 / 16 + 3) : 255, ntile = (nblk + 63) >> 6;
    float mfin, inv;
    { Acc a; acc_init(a);
      flash_stage<1, 16, 8>(&a, qr, KC, VC, 64, RangeIt{0, ntile}, DqCmp{t - 31 - 64 * hi}, 0x7fffffffu, slope2, slots, w, lane);
      const float l = a.l + __shfl_xor(a.l, 32); inv = l > 0.f ? frcp(l) : 0.f; mfin = a.m;
      const float c = NSA_GATE(0) * inv;
#pragma unroll
      for (int r = 0; r < 16; ++r) { out0[r] = a.o0[r] * c; out1[r] = a.o1[r] * c; } }
    { float vprev = 0.f; int s = 0; int lane = F.lane; asm volatile("" : "+v"(lane)); const int r32 = lane & 31, hi = lane >> 5, ql = 32 * (w & 1) + r32;
      dma_kv<8>(KC, VC, 64, 0, slots, slots + 8192, w, lane);
      for (int kt = 0; kt < ntile; ++kt) {
          VM_WAIT(); __syncthreads();
          if (kt + 1 < ntile) dma_kv<8>(KC, VC, 64, 64 * (kt + 1), slots + (s ^ 1) * 16384, slots + (s ^ 1) * 16384 + 8192, w, lane);
          f32x16 p0, p1; score_tile<0, 4, 16>(p0, p1, slots + s * 16384, qr, t - 31 - 64 * hi - 1024 * kt, 0x7fffffffu, slope2, r32, hi);
          LAS float* ip = impL + (size_t)(h * 64 + ql) * 65 + 16 * kt + hi;
#pragma unroll
          for (int ph = 0; ph < 2; ++ph)
#pragma unroll
              for (int g = 0; g < 4; ++g) { float x[4];
#pragma unroll
                  for (int k = 0; k < 4; ++k) { const float sv = ph ? p1[4 * g + k] : p0[4 * g + k]; x[k] = sv > -1e29f ? fexp2(sv - mfin) * inv : 0.f; }
                  const float hb = 0.5f * x[3], v = __shfl_xor(hb, 32), add = hi ? v : vprev; vprev = v;
                  ip[8 * ph + 2 * g] = x[0] + x[1] + x[2] + hb + add; }
          s ^= 1; }
      LDS_WAIT(); __syncthreads(); }
    { const int tb = q0 >> 6; int ln = lane; asm volatile("" : "+v"(ln));
#pragma nounroll
      for (int i = 0; i < 8; ++i) { const int qq = 8 * w + i; const LAS float* ib = impL + (size_t)qq * 65 + ln;
          float v = ib[0] + ib[64 * 65] + ib[2 * 64 * 65] + ib[3 * 64 * 65];
          const bool forced = (ln == 0) || (ln == tb) || (ln == tb - 1), future = ln > tb;
          v = forced ? 1e9f : (future ? -1.0f : v);
          int cnt = 0;
#pragma unroll 8
          for (int jj = 0; jj < 64; ++jj) { const float vj = __builtin_bit_cast(float, __builtin_amdgcn_readlane(__builtin_bit_cast(int, v), jj)); cnt += (vj > v || (vj == v && jj < ln)) ? 1 : 0; }
          const unsigned long long mk = __ballot(cnt < 16 && !future);
          if (ln == 0) selm[qq] = mk; }
      LDS_WAIT(); __syncthreads(); }
    const bf16_t* Pb = PROJ + (size_t)b * SEQ * NPP + PC_KVA;
    { int l3 = F.lane; asm volatile("" : "+v"(l3));
      unsigned long long U = selm[l3];
      unsigned lo = (unsigned)U, hiw = (unsigned)(U >> 32);
#pragma unroll
      for (int o = 1; o < 64; o <<= 1) { lo |= __shfl_xor(lo, o); hiw |= __shfl_xor(hiw, o); }
      U = ((unsigned long long)(unsigned)__builtin_amdgcn_readfirstlane(hiw) << 32) | (unsigned)__builtin_amdgcn_readfirstlane(lo);
      const unsigned long long mine = selm[32 * (w & 1) + (l3 & 31)];
      Acc a; acc_init(a);
      flash_stage<1, 1, 8>(&a, qr, Pb + 2 * 64, Pb + 3 * 64, NPP, BitsIt{U}, DqSel{t - 4 * hi, mine}, 0x7fffffffu, slope2, slots, w, lane);
      const float l = a.l + __shfl_xor(a.l, 32), c = NSA_GATE(1) * (l > 0.f ? frcp(l) : 0.f);
#pragma unroll
      for (int r = 0; r < 16; ++r) { out0[r] += a.o0[r] * c; out1[r] += a.o1[r] * c; } }
    { Acc a; acc_init(a);
      flash_stage<1, 1, 8>(&a, qr, Pb + 4 * 64, Pb + 5 * 64, NPP, RangeIt{qblk >= 8 ? qblk - 8 : 0, qblk + 1}, DqCausal{t - 4 * hi}, 512u, slope2, slots, w, lane);
      const float l = a.l + __shfl_xor(a.l, 32), c = NSA_GATE(2) * (l > 0.f ? frcp(l) : 0.f);
#pragma unroll
      for (int r = 0; r < 16; ++r) { out0[r] += a.o0[r] * c; out1[r] += a.o1[r] * c; } }
    { int l4 = F.lane; asm volatile("" : "+v"(l4));
      store_ot(ws_bf(F, WS_AO) + ((size_t)b * SEQ + q0 + 32 * (w & 1) + (l4 & 31)) * D + h * 64, out0, out1, l4 >> 5); }
}

template <int MODE> __device__ __forceinline__ void ln_phase(Frame& F, const float* gam, const float* bet, bool write_xb) {
    const int lane = F.lane, w = F.wave, RPC = M / F.G, cu = blockIdx.x;
    const float* Y = (const float*)(F.ws + WS_Y);
    bf16_t* XB = ws_bf(F, WS_XB);
    LAS float* wrT = (LAS float*)F.lds;
    LAS int* histL = (LAS int*)(F.lds + 32768);
    int* route = (int*)(F.ws + WS_TAB + TB_ROUTE);
    if (MODE == 1) {
        const float* wr = inp(15);
        for (int i = F.tid; i < 8192; i += NTHREADS) wrT[(i & 7) * 1024 + (i >> 3)] = wr[i];
        if (F.tid < 8) histL[F.tid] = 0;
        LDS_WAIT(); __syncthreads();
    }
    f32x4 gv[4], bv[4];
#pragma unroll
    for (int j = 0; j < 4; ++j) { gv[j] = *(const f32x4*)(gam + 4 * lane + 256 * j); bv[j] = *(const f32x4*)(bet + 4 * lane + 256 * j); }
    for (int rr = w; rr < RPC; rr += NWAVES) {
        const size_t row = (size_t)cu * RPC + rr;
        f32x4 v[4];
        if (MODE == 2) {
            const int* rt = route + row * 8; const float g1 = __builtin_bit_cast(float, rt[2]), g2 = __builtin_bit_cast(float, rt[3]);
            const bf16_t* y1 = ws_bf(F, WS_XS) + (size_t)rt[4] * D; const bf16_t* y2 = ws_bf(F, WS_XS) + (size_t)rt[5] * D;
#pragma unroll
            for (int j = 0; j < 4; ++j) { const f32x4 x = *(const f32x4*)(F.out + row * D + 4 * lane + 256 * j);
                const u32x2 a = *(const u32x2*)(y1 + 4 * lane + 256 * j), b = *(const u32x2*)(y2 + 4 * lane + 256 * j);
                f32x4 fa = {__builtin_bit_cast(float, a.x << 16), __builtin_bit_cast(float, a.x & 0xffff0000u), __builtin_bit_cast(float, a.y << 16), __builtin_bit_cast(float, a.y & 0xffff0000u)};
                f32x4 fb = {__builtin_bit_cast(float, b.x << 16), __builtin_bit_cast(float, b.x & 0xffff0000u), __builtin_bit_cast(float, b.y << 16), __builtin_bit_cast(float, b.y & 0xffff0000u)};
                v[j] = x * DN_ALPHA + fa * g1 + fb * g2; }
        } else {
#pragma unroll
            for (int j = 0; j < 4; ++j) v[j] = *(const f32x4*)(Y + row * D + 4 * lane + 256 * j);
        }
        float s = 0.f;
#pragma unroll
        for (int j = 0; j < 4; ++j) s += (v[j][0] + v[j][1]) + (v[j][2] + v[j][3]);
        const float mean = wave_sum(s) * (1.0f / D); float s2 = 0.f;
#pragma unroll
        for (int j = 0; j < 4; ++j) { v[j] = v[j] - mean; s2 += (v[j][0] * v[j][0] + v[j][1] * v[j][1]) + (v[j][2] * v[j][2] + v[j][3] * v[j][3]); }
        const float rstd = __builtin_amdgcn_rsqf(wave_sum(s2) * (1.0f / D) + LN_EPS);
#pragma unroll
        for (int j = 0; j < 4; ++j) { v[j] = v[j] * rstd * gv[j] + bv[j]; *(f32x4*)(F.out + row * D + 4 * lane + 256 * j) = v[j]; }
        if (write_xb) {
#pragma unroll
            for (int j = 0; j < 4; ++j) { u32x2 o; o.x = pk2(v[j][0], v[j][1]); o.y = pk2(v[j][2], v[j][3]); *(u32x2*)(XB + row * D + 4 * lane + 256 * j) = o; }
        }
        if (MODE == 1) {
            float lg[8];
#pragma unroll
            for (int e = 0; e < 8; ++e) { float p = 0.f;
#pragma unroll
                for (int j = 0; j < 4; ++j) { const f32x4 ww = *(const LAS f32x4*)(wrT + e * 1024 + 4 * lane + 256 * j); p += (v[j][0] * ww[0] + v[j][1] * ww[1]) + (v[j][2] * ww[2] + v[j][3] * ww[3]); }
                lg[e] = wave_sum(p); }
            int e1 = 0; float l1 = lg[0];
#pragma unroll
            for (int e = 1; e < 8; ++e) if (lg[e] > l1) { l1 = lg[e]; e1 = e; }
            int e2 = -1; float l2 = -3.0e38f;
#pragma unroll
            for (int e = 0; e < 8; ++e) if (e != e1 && lg[e] > l2) { l2 = lg[e]; e2 = e; }
            const float ex = __expf(l2 - l1), g1 = 1.0f / (1.0f + ex), g2 = ex * g1;
            if (lane == 0) { int* rt = route + row * 8; rt[0] = e1; rt[1] = e2; rt[2] = __builtin_bit_cast(int, g1); rt[3] = __builtin_bit_cast(int, g2);
                __hip_atomic_fetch_add(histL + e1, 1, __ATOMIC_RELAXED, __HIP_MEMORY_SCOPE_WORKGROUP); __hip_atomic_fetch_add(histL + e2, 1, __ATOMIC_RELAXED, __HIP_MEMORY_SCOPE_WORKGROUP); }
        }
    }
    if (MODE == 1) { LDS_WAIT(); __syncthreads(); if (F.tid < 8) ((int*)(F.ws + WS_TAB + TB_HIST))[cu * 8 + F.tid] = histL[F.tid]; }
}

__device__ __forceinline__ void moe_dispatch(Frame& F) {
    const int lane = F.lane, w = F.wave, RPC = M / F.G, cu = blockIdx.x;
    LAS int* L = (LAS int*)F.lds;
    const int* hist = (const int*)(F.ws + WS_TAB + TB_HIST);
    int* route = (int*)(F.ws + WS_TAB + TB_ROUTE);
    if (F.tid < 8) { int pre = 0, tot = 0; for (int c = 0; c < F.G; ++c) { const int hc = hist[c * 8 + F.tid]; pre += (c < cu) ? hc : 0; tot += hc; } L[F.tid] = pre; L[8 + F.tid] = tot; }
    LDS_WAIT(); __syncthreads();
    if (F.tid == 0) { int sb = 0; for (int e = 0; e < 8; ++e) { L[16 + e] = sb; sb += ((L[8 + e] + 255) >> 8) << 8; } L[24] = sb;
        if (cu == 0) { int* meta = (int*)(F.ws + WS_TAB + TB_META); for (int e = 0; e < 9; ++e) meta[e] = L[16 + e]; for (int e = 0; e < 8; ++e) meta[16 + e] = L[8 + e];
            for (int e = 0; e < 8; ++e) for (int tl = L[16 + e] >> 8; tl < (L[17 + e] >> 8); ++tl) meta[32 + tl] = e; } }
    LDS_WAIT(); __syncthreads();
    if (w == 0) {
        const size_t tok = (size_t)cu * RPC + lane; int* rt = route + tok * 8; const int e1 = rt[0], e2 = rt[1];
        const unsigned long long lt = (1ull << lane) - 1ull, le = lt | (1ull << lane);
        int pos1 = 0, pos2 = 0;
#pragma unroll
        for (int e = 0; e < 8; ++e) { const unsigned long long m0 = __ballot(e1 == e), m1 = __ballot(e2 == e); const int base = L[16 + e] + L[e];
            if (e1 == e) pos1 = base + __builtin_popcountll(m0 & lt) + __builtin_popcountll(m1 & lt);
            if (e2 == e) pos2 = base + __builtin_popcountll(m0 & le) + __builtin_popcountll(m1 & lt); }
        rt[4] = pos1; rt[5] = pos2; L[32 + 2 * lane] = pos1; L[33 + 2 * lane] = pos2;
    }
    LDS_WAIT(); __syncthreads();
    const bf16_t* XB = ws_bf(F, WS_XB); bf16_t* XS = ws_bf(F, WS_XS);
    for (int a = w; a < 2 * RPC; a += NWAVES) { const size_t tok = (size_t)cu * RPC + (a >> 1); const int pos = L[32 + a];
        const u32x4* s = (const u32x4*)(XB + tok * D); u32x4* d = (u32x4*)(XS + (size_t)pos * D);
        d[lane] = s[lane]; d[64 + lane] = s[64 + lane]; }
}

constexpr int PH_PER_LAYER = 11, N_PHASES = 1 + DEPTH * PH_PER_LAYER;
struct Args { const float* in[25]; float* out; unsigned char* ws; int ph_lo, ph_hi, li, pad; };

__device__ __forceinline__ void run_phase(Frame& F, int ph) {
    using namespace pg8;
#ifndef PHSEL
#define PHSEL 0xFFF
#endif
    if (ph == 0) { int z0 = 0; asm volatile("" : "+v"(z0)); F.lane = (int)__builtin_amdgcn_mbcnt_hi(~0u, __builtin_amdgcn_mbcnt_lo(~0u, (unsigned)z0)); F.tid = F.wave * 64 + F.lane; if (PHSEL & 0x800) p0_prologue(F); return; }
    const int L = (ph - 1) / PH_PER_LAYER, k = (ph - 1) % PH_PER_LAYER;
    const bool moe = (L & 1) != 0;
    int cid = (int)blockIdx.x; asm volatile("" : "+s"(cid));
    { int wv_ = F.wave; asm volatile("" : "+s"(wv_)); F.wave = wv_; }
    { int z_ = 0; asm volatile("" : "+v"(z_)); F.lane = (int)__builtin_amdgcn_mbcnt_hi(~0u, __builtin_amdgcn_mbcnt_lo(~0u, (unsigned)z_)); F.tid = F.wave * 64 + F.lane; }
    { unsigned char* w_ = F.ws; asm volatile("" : "+s"(w_)); F.ws = w_; }
    unsigned char* ws = F.ws;
    switch (k) {
    case 0: if (PHSEL & (1 << 0)) {
        Gemm g{ws_bf(F, WS_XB), ws_bf(F, L ? WS_WIN1 : WS_WIN0), D, D}; StaticOrder S; S.init(M / 256, NPP / 256, F.G, cid);
        EpiBf16<0> E{ws_bf(F, WS_PROJ), NPP};
        gemm_phase(F.lds, g, S, E, F.wave);
    } break;
    case 1: if (PHSEL & (1 << 1)) {
        const float lam_init = 0.8f - 0.6f * __expf(-0.3f * (float)L);
        float lam;
        { const float* dl = inp(6) + L * 128; const int l = F.lane & 31; const float a = dl[l] * dl[32 + l], b = dl[64 + l] * dl[96 + l];
          float sa = (F.lane < 32) ? a : 0.f, sb = (F.lane < 32) ? b : 0.f; sa = wave_sum(sa); sb = wave_sum(sb); lam = __expf(sa) - __expf(sb) + lam_init; }
        for (int u = cid; u < 256; u += F.G) { const int b = u >> 6, h = (u >> 4) & 3, s = u & 15;
            diff_unit(F, L, b, h, 31 - s, lam, 1.0f - lam_init); diff_unit(F, L, b, h, s, lam, 1.0f - lam_init); }
        for (int u = cid; u < 64; u += F.G) compress_unit(F, L, u >> 5, (u >> 3) & 3, u & 7);
        for (int u = cid; u < 512; u += F.G) swa_unit(F, L, u >> 7, (u >> 6) & 1, u & 63);
    } break;
    case 2: if (PHSEL & (1 << 2)) {
        for (int u = cid; u < 256; u += F.G) nsa_unit(F, L, u >> 6, u & 63);
    } break;
    case 3: if (PHSEL & (1 << 3)) {
        Gemm g{ws_bf(F, WS_AO), ws_bf(F, L ? WS_WOUT1 : WS_WOUT0), D, D}; StaticOrder S; S.init(M / 256, D / 256, F.G, cid);
        EpiResid<0> E{L ? F.out : inp(0), (float*)(ws + WS_Y), nullptr, D};
        gemm_phase(F.lds, g, S, E, F.wave);
    } break;
    case 4: if (PHSEL & (1 << 4)) {
        if (moe) ln_phase<1>(F, inp(10) + L * D, inp(11) + L * D, true); else ln_phase<0>(F, inp(10) + L * D, inp(11) + L * D, true);
        cvt_rows(inp(1) + (size_t)L * M * PLE, ws_bf(F, WS_PB), (size_t)M * PLE / 8, (size_t)blockIdx.x * NTHREADS + F.tid, (size_t)F.G * NTHREADS);
    } break;
    case 5: if (PHSEL & (1 << 5)) {
        if (!moe) { Gemm g{ws_bf(F, WS_XB), ws_bf(F, WS_FGU), D, D}; StaticOrder S; S.init(M / 256, 2 * FF / 256, F.G, cid);
            EpiBf16<1> E{ws_bf(F, WS_H), FF}; gemm_phase(F.lds, g, S, E, F.wave); }
        else moe_dispatch(F);
    } break;
    case 6: if (PHSEL & (1 << 6)) {
        if (!moe) { Gemm g{ws_bf(F, WS_H), ws_bf(F, WS_FD), FF, FF}; StaticOrder S; S.init(M / 256, D / 256, F.G, cid);
            EpiResid<0> E{F.out, (float*)(ws + WS_Y), nullptr, D}; gemm_phase(F.lds, g, S, E, F.wave); }
        else { const int* meta = (const int*)(ws + WS_TAB + TB_META);
            MoeOrder S; S.so.init(__builtin_amdgcn_readfirstlane(meta[8]) >> 8, 2 * FE / 256, F.G, cid); S.tile_e = meta + 32;
            Gemm g{ws_bf(F, WS_XS), ws_bf(F, WS_MOE_GU), D, D}; EpiBf16<1> E{ws_bf(F, WS_HM), FE}; gemm_phase(F.lds, g, S, E, F.wave); }
    } break;
    case 7: if (PHSEL & (1 << 7)) {
        if (moe) { const int* meta = (const int*)(ws + WS_TAB + TB_META);
            MoeOrder S; S.so.init(__builtin_amdgcn_readfirstlane(meta[8]) >> 8, D / 256, F.G, cid); S.tile_e = meta + 32;
            Gemm g{ws_bf(F, WS_HM), ws_bf(F, WS_MOE_D), FE, FE}; EpiBf16<0> E{ws_bf(F, WS_XS), D}; gemm_phase(F.lds, g, S, E, F.wave); }
    } break;
    case 8: if (PHSEL & (1 << 8)) {
        if (moe) ln_phase<2>(F, inp(19) + L * D, inp(20) + L * D, true); else ln_phase<0>(F, inp(19) + L * D, inp(20) + L * D, true);
        __syncthreads();
        Gemm g{ws_bf(F, WS_PB), ws_bf(F, L ? WS_PLEP1 : WS_PLEP0), PLE, PLE}; StaticOrder S; S.init(M / 256, D / 256, F.G, cid);
        EpiBf16<0> E{ws_bf(F, WS_U), D}; gemm_phase(F.lds, g, S, E, F.wave);
    } break;
    case 9: if (PHSEL & (1 << 9)) {
        Gemm g{ws_bf(F, WS_XB), ws_bf(F, L ? WS_PLEG1 : WS_PLEG0), D, D}; StaticOrder S; S.init(M / 256, D / 256, F.G, cid);
        EpiResid<1> E{F.out, (float*)(ws + WS_Y), ws_bf(F, WS_U), D}; gemm_phase(F.lds, g, S, E, F.wave);
    } break;
    case 10: if (PHSEL & (1 << 10)) {
        ln_phase<0>(F, inp(23) + L * D, inp(24) + L * D, L + 1 < DEPTH);
    } break;
    default: break;
    }
}
__device__ __forceinline__ bool phase_empty(int ph) { if (ph == 0) return false; const int L = (ph - 1) / PH_PER_LAYER, k = (ph - 1) % PH_PER_LAYER; return k == 7 && (L & 1) == 0; }

__global__ void __launch_bounds__(NTHREADS, 2) mk_fwd(Args args) {
    extern __shared__ __attribute__((aligned(16))) unsigned char lds_raw[];
    Frame F;
    F.lds = (LAS unsigned char*)lds_raw;
    F.tid = threadIdx.x; F.lane = F.tid & 63; F.wave = __builtin_amdgcn_readfirstlane(F.tid >> 6);
    { const int bx = blockIdx.x; F.vcu = (bx % 8) * (GRID / 8) + bx / 8; }
    F.ws = args.ws; F.out = args.out;
    for (int u = F.tid; u < (LDS_BYTES - LDSCTL_OFF) / 4; u += NTHREADS) ((LAS unsigned*)(F.lds + LDSCTL_OFF))[u] = 0u;
    __syncthreads();
    unsigned* ctl = (unsigned*)(F.ws + WS_CTL);
    XcdBarrier bar; bar.bar = ctl + CW_BAR + args.li * XCD_BAR_WORDS; bar.x = 0; bar.st = nullptr;
    const bool multi = (args.ph_hi - args.ph_lo) > 1;
    if (multi) bar = xcd_barrier_post(ctl + CW_BAR + args.li * XCD_BAR_WORDS, (volatile LAS unsigned*)(F.lds + MISC_OFF) + 8);
    bool first = true;
    for (int ph = args.ph_lo; ph < args.ph_hi; ++ph) {
        if (phase_empty(ph)) continue;
        int nrep = 1;
#ifdef PROBE_REP
        nrep += (ph == 0) ? ((PROBE_REP >> 11) & 1) : ((PROBE_REP >> ((ph - 1) % PH_PER_LAYER)) & 1);
#endif
#pragma nounroll
        for (int rep = 0; rep < nrep; ++rep) {
            if (!first) { int z_ = 0; asm volatile("" : "+v"(z_)); const int ln = (int)__builtin_amdgcn_mbcnt_hi(~0u, __builtin_amdgcn_mbcnt_lo(~0u, (unsigned)z_)); xcd_barrier(bar, F.wave == 0 && ln == 0); }
            run_phase(F, ph);
            first = false;
        }
    }
}

extern "C" void kernel_launch(void* const* d_in, const int* in_sizes, int n_in, void* d_out, int out_size, void* d_ws, size_t ws_size, hipStream_t stream) {
    static int grid = 0;
    if (grid == 0) {
        if (n_in != 25 || out_size != M * D || ws_size < WS_END) { fprintf(stderr, "kernel_launch: unexpected sizes n_in %d out %d ws %zu (need %zu)\n", n_in, out_size, ws_size, (size_t)WS_END); grid = -1; return; }
        int dev = 0, cus = 0, per_cu = 0;
        if (hipGetDevice(&dev) != hipSuccess || hipDeviceGetAttribute(&cus, hipDeviceAttributeMultiprocessorCount, dev) != hipSuccess) { grid = -1; return; }
        if (hipFuncSetAttribute((const void*)mk_fwd, hipFuncAttributeMaxDynamicSharedMemorySize, LDS_BYTES) != hipSuccess) { fprintf(stderr, "kernel_launch: hipFuncSetAttribute failed\n"); grid = -1; return; }
        if (hipOccupancyMaxActiveBlocksPerMultiprocessor(&per_cu, (const void*)mk_fwd, NTHREADS, LDS_BYTES) != hipSuccess || per_cu < 1) { fprintf(stderr, "kernel_launch: occupancy query says %d blocks per CU\n", per_cu); (void)hipGetLastError(); grid = -1; return; }
        if (cus < 256) { fprintf(stderr, "kernel_launch: needs 256 CUs, device has %d\n", cus); grid = -1; return; }
        grid = 256;
    }
    if (grid < 0) return;
    (void)hipMemsetAsync((char*)d_ws + WS_CTL, 0, CTL_ZERO_BYTES, stream);
    Args a{};
    for (int i = 0; i < 25; ++i) a.in[i] = (const float*)d_in[i];
    a.out = (float*)d_out; a.ws = (unsigned char*)d_ws;
#if MK_N_LAUNCHES == 1
    a.ph_lo = 0; a.ph_hi = N_PHASES; a.li = 0;
    hipLaunchKernelGGL(mk_fwd, dim3(grid), dim3(NTHREADS), LDS_BYTES, stream, a);
#else
    for (int ph = 0; ph < N_PHASES; ++ph) { a.ph_lo = ph; a.ph_hi = ph + 1; a.li = 0;
        hipLaunchKernelGGL(mk_fwd, dim3(grid), dim3(NTHREADS), LDS_BYTES, stream, a); }
#endif
}
```

```cpp
#include <hip/hip_runtime.h>
#include <hip/hip_bf16.h>
#include <cstdint>
#include <cstdio>

#define GAS __attribute__((address_space(1)))
#define LAS __attribute__((address_space(3)))
typedef unsigned short bf16_t;
typedef short bf16x8 __attribute__((ext_vector_type(8)));
typedef short s16x4 __attribute__((ext_vector_type(4)));
typedef float f32x2 __attribute__((ext_vector_type(2)));
typedef float f32x4 __attribute__((ext_vector_type(4)));
typedef float f32x16 __attribute__((ext_vector_type(16)));
typedef unsigned u32x2 __attribute__((ext_vector_type(2)));
typedef unsigned u32x4 __attribute__((ext_vector_type(4)));

#ifndef MK_N_LAUNCHES
#define MK_N_LAUNCHES 1
#endif

constexpr int D = 1024, BATCH = 4, SEQ = 4096, M = BATCH * SEQ, DEPTH = 2;
constexpr int NPROJ = 2188, NPP = 2304;
constexpr int PC_QA = 0, PC_KVA = 256, PC_QB = 640, PC_KB = 896, PC_VB = 1152, PC_QC = 1408, PC_KC = 1920, PC_VC = 2048, PC_GA = 2176;
constexpr int FF = 2816, FE = 3584, NE = 8, PLE = 256;
constexpr int NCAP = 136 * 256;
constexpr float LN_EPS = 1e-5f;
constexpr float DN_ALPHA = 1.4142135623730951f;
constexpr float LOG2E = 1.4426950408889634f;
constexpr float NEGBIG = -1e30f;

constexpr size_t MiB = 1u << 20;
constexpr size_t WS_CTL = 0, CTL_ZERO_BYTES = 1 * MiB;
constexpr size_t WS_TAB = 1 * MiB;
constexpr size_t WS_MOE_GU = 2 * MiB;
constexpr size_t WS_MOE_D = 114 * MiB;
constexpr size_t WS_PLEG1 = 170 * MiB, WS_PLEP1 = 172 * MiB;
constexpr size_t WS_WIN1 = 173 * MiB, WS_WOUT1 = 178 * MiB, WS_CW1_1 = 180 * MiB;
constexpr size_t WS_R = 181 * MiB;
constexpr size_t WS_WIN0 = 181 * MiB, WS_WOUT0 = 186 * MiB, WS_FGU = 188 * MiB, WS_FD = 199 * MiB, WS_PLEG0 = 205 * MiB, WS_PLEP0 = 207 * MiB;
constexpr size_t WS_Y = 208 * MiB;
constexpr size_t WS_XB = 272 * MiB;
constexpr size_t WS_BIG = 304 * MiB;
constexpr size_t WS_PROJ = WS_BIG;
constexpr size_t WS_AO = WS_BIG + 72 * MiB;
constexpr size_t WS_KCV = WS_BIG + 104 * MiB;
constexpr size_t WS_CW1_0 = WS_BIG + 106 * MiB;
constexpr size_t WS_H = WS_BIG;
constexpr size_t WS_PB = 488 * MiB;
constexpr size_t WS_U = WS_BIG + 8 * MiB;
constexpr size_t WS_HM = WS_R;
constexpr size_t WS_XS = 420 * MiB;
constexpr size_t WS_END = 496 * MiB;
constexpr size_t TB_CBIAS = 0;
constexpr size_t TB_CW2 = 8192;
constexpr size_t TB_ROUTE = 128 * 1024;
constexpr size_t TB_HIST = TB_ROUTE + (size_t)M * 32;
constexpr size_t TB_META = TB_HIST + 256 * 8 * 4;
static_assert(TB_META + 1024 <= 1 * MiB, "tables");
static_assert(WS_HM + (size_t)NCAP * FE * 2 <= WS_XS && WS_XS + (size_t)NCAP * D * 2 <= WS_PB, "moe map");

constexpr int CW_TMO = 0, CW_CODE = 1, CW_BAR = 4096;

constexpr int RING_BYTES = 131072;
constexpr int LDSCTL_OFF = RING_BYTES, MISC_OFF = LDSCTL_OFF + 320;
constexpr int LDS_BYTES = 147456;
constexpr int NWAVES = 8, NTHREADS = 512, GRID = 256;

#define RLX_AGENT __ATOMIC_RELAXED, __HIP_MEMORY_SCOPE_AGENT
#define LDS_WAIT() asm volatile("s_waitcnt lgkmcnt(0)" ::: "memory")
#define VM_WAIT() asm volatile("s_waitcnt vmcnt(0)" ::: "memory")
__device__ __forceinline__ unsigned f2bf(float f) { unsigned u = __builtin_bit_cast(unsigned, f); return (u + 0x7fffu + ((u >> 16) & 1u)) >> 16; }
__device__ __forceinline__ unsigned pk2(float lo, float hi) { return f2bf(lo) | (f2bf(hi) << 16); }
__device__ __forceinline__ float bf2f(unsigned short b) { return __builtin_bit_cast(float, (unsigned)b << 16); }
__device__ __forceinline__ unsigned cvt_pk_bf16(float lo, float hi) { unsigned r; asm volatile("v_cvt_pk_bf16_f32 %0, %1, %2" : "=v"(r) : "v"(lo), "v"(hi)); return r; }
__device__ __forceinline__ float fexp2(float x) { return __builtin_amdgcn_exp2f(x); }
__device__ __forceinline__ float frcp(float x) { return __builtin_amdgcn_rcpf(x); }
__device__ __forceinline__ float sigmoidf_(float x) { return frcp(1.0f + fexp2(-x * LOG2E)); }
__device__ __forceinline__ float wave_sum(float v) {
#pragma unroll
    for (int o = 1; o < 64; o <<= 1) v += __shfl_xor(v, o);
    return v;
}

namespace pg8 {
constexpr int BM = 256, BK = 64, HALF = 128, HTB = HALF * BK * 2, STAGE_BYTES = 8 * HTB, NXCD = 8, WGM = 8;
__host__ __device__ __forceinline__ int lds_byte(int r, int c) { const int st = (r >> 4) * 2 + (c >> 5), rr = r & 15, cc = c & 31, ob = rr * 64 + cc * 2; return st * 1024 + (ob ^ (((ob >> 9) & 1) << 5)); }
__host__ __device__ __forceinline__ void stage_rc(int b, int& R, int& C) { const int st = b / 1024, sb = b % 1024, swz = sb ^ (((sb >> 9) & 1) << 5); R = (st >> 1) * 16 + swz / 64; C = (st & 1) * 32 + (swz % 64) / 2; }
__host__ __device__ __forceinline__ int perm32(int rho) { const int n = rho >> 4, i = rho & 15; return 8 * (i >> 2) + 4 * n + (i & 3); }

struct Unit { int pm, pn, pb; };
struct Gemm { const bf16_t* A; const bf16_t* Bt; int lda; int K; };

struct StaticOrder {
    int nM, nN, nwg, G, c;
    __device__ void init(int nM_, int nN_, int G_, int c_) { nM = nM_; nN = nN_; nwg = nM * nN; G = G_; c = c_; }
    __device__ bool next(int i, Unit& u) const {
        const long L = (long)i * G + c; if (L >= nwg) return false;
        int wgid = (int)L; { const int q = nwg / NXCD, r = nwg % NXCD, xcd = wgid % NXCD, off = wgid / NXCD; wgid = (xcd < r ? xcd * (q + 1) : r * (q + 1) + (xcd - r) * q) + off; }
        const int nig = WGM * nN, gid = wgid / nig, fm = gid * WGM, gsz = (nM - fm) < WGM ? (nM - fm) : WGM;
        u.pm = fm + ((wgid % nig) % gsz); u.pn = (wgid % nig) / gsz; u.pb = u.pn; return true;
    }
};
struct MoeOrder {
    StaticOrder so; const int* tile_e;
    __device__ bool next(int i, Unit& u) const {
        if (!so.next(i, u)) return false;
        u.pb = __builtin_amdgcn_readfirstlane(tile_e[u.pm]) * so.nN + u.pn; return true;
    }
};

template <int MODE> struct EpiBf16 {
    static constexpr bool PERM = true;
    bf16_t* O; int ldc;
    __device__ __forceinline__ void operator()(const f32x4 (&acc)[2][2][4][2], const Unit& u, int wr, int wc, int fr, int fq) const {
        const int row0 = u.pm * BM + wr * 64 + fr;
        if (MODE == 0) {
            const int col0 = u.pn * BM + wc * 32 + 8 * fq;
#pragma unroll
            for (int ai = 0; ai < 2; ++ai)
#pragma unroll
                for (int m = 0; m < 4; ++m) { bf16_t* rowp = O + (size_t)(row0 + ai * HALF + m * 16) * ldc + col0;
#pragma unroll
                    for (int bj = 0; bj < 2; ++bj) { const f32x4 v0 = acc[ai][bj][m][0], v1 = acc[ai][bj][m][1];
                        u32x4 w; w.x = cvt_pk_bf16(v0[0], v0[1]); w.y = cvt_pk_bf16(v0[2], v0[3]); w.z = cvt_pk_bf16(v1[0], v1[1]); w.w = cvt_pk_bf16(v1[2], v1[3]);
                        *(u32x4*)(rowp + bj * HALF) = w; } }
        } else {
            const int col0 = u.pn * HALF + wc * 32 + 8 * fq;
#pragma unroll
            for (int ai = 0; ai < 2; ++ai)
#pragma unroll
                for (int m = 0; m < 4; ++m) { bf16_t* rowp = O + (size_t)(row0 + ai * HALF + m * 16) * ldc + col0;
                    u32x4 w;
#pragma unroll
                    for (int n = 0; n < 2; ++n) { const f32x4 g = acc[ai][0][m][n], up = acc[ai][1][m][n]; float h0, h1, h2, h3;
                        h0 = g[0] * up[0] * frcp(1.0f + fexp2(-g[0] * LOG2E)); h1 = g[1] * up[1] * frcp(1.0f + fexp2(-g[1] * LOG2E));
                        h2 = g[2] * up[2] * frcp(1.0f + fexp2(-g[2] * LOG2E)); h3 = g[3] * up[3] * frcp(1.0f + fexp2(-g[3] * LOG2E));
                        if (n == 0) { w.x = cvt_pk_bf16(h0, h1); w.y = cvt_pk_bf16(h2, h3); } else { w.z = cvt_pk_bf16(h0, h1); w.w = cvt_pk_bf16(h2, h3); } }
                    asm volatile("" ::: "memory");
                    *(u32x4*)rowp = w; }
        }
    }
};
template <int MODE> struct EpiResid {
    static constexpr bool PERM = false;
    const float* base; float* out; const bf16_t* U; int ldc;
    __device__ __forceinline__ void operator()(const f32x4 (&acc)[2][2][4][2], const Unit& u, int wr, int wc, int fr, int fq) const {
        const int col0 = u.pn * BM + wc * 32 + 4 * fq;
#pragma unroll
        for (int ai = 0; ai < 2; ++ai)
#pragma unroll
            for (int m = 0; m < 4; ++m) { const size_t off = (size_t)(u.pm * BM + ai * HALF + wr * 64 + m * 16 + fr) * ldc + col0;
#pragma unroll
                for (int bj = 0; bj < 2; ++bj)
#pragma unroll
                    for (int n = 0; n < 2; ++n) { const size_t o2 = off + bj * HALF + n * 16; const f32x4 bs = *(const f32x4*)(base + o2); f32x4 a = acc[ai][bj][m][n];
                        if (MODE == 1) { const u32x2 uu = *(const u32x2*)(U + o2);
                            a[0] = sigmoidf_(a[0]) * __builtin_bit_cast(float, uu.x << 16); a[1] = sigmoidf_(a[1]) * __builtin_bit_cast(float, uu.x & 0xffff0000u);
                            a[2] = sigmoidf_(a[2]) * __builtin_bit_cast(float, uu.y << 16); a[3] = sigmoidf_(a[3]) * __builtin_bit_cast(float, uu.y & 0xffff0000u); }
                        *(f32x4*)(out + o2) = bs * DN_ALPHA + a; }
                asm volatile("" ::: "memory"); }
    }
};

#ifndef PG8_SP2
#define PG8_SP2 true
#endif
template <class Epi, class Sched, bool ALIGN_EPI = true, bool SP2 = PG8_SP2>
__device__ __forceinline__ void gemm_phase(LAS unsigned char* lds, const Gemm g, const Sched& S, const Epi& E, int wid_) {
    int z_ = 0; asm volatile("" : "+v"(z_));
    const int lane = (int)__builtin_amdgcn_mbcnt_hi(~0u, __builtin_amdgcn_mbcnt_lo(~0u, (unsigned)z_)), wid = wid_, tid = wid * 64 + lane, wr = wid >> 2, wc = wid & 3, fr = lane & 15, fq = lane >> 4;
    const int K = g.K, nt = K / BK;
    unsigned voffA[2], voffB[2];
#pragma unroll
    for (int i = 0; i < 2; ++i) { int R, C; stage_rc(tid * 16 + i * 8192, R, C); const int Rb = Epi::PERM ? ((R & ~31) + perm32(R & 31)) : R;
        voffA[i] = (unsigned)(R * g.lda + C) * 2u; voffB[i] = (unsigned)(Rb * K + C) * 2u; }
    const size_t kstep = (size_t)(BK * 2);
    const size_t hstepA = (size_t)HALF * g.lda * 2, tstepA = 2 * hstepA;
    const size_t hstepB = (size_t)HALF * K * 2, tstepB = 2 * hstepB;
    const unsigned ldsw = (unsigned)wid * 1024u;
    const int aoff = lds_byte(wr * 64 + fr, fq * 8), boff = lds_byte(wc * 32 + fr, fq * 8);
#define PG8_SA(b, h) (((b) * 2 + (h)) * HTB)
#define PG8_SB(b, h) ((4 + (b) * 2 + (h)) * HTB)
#define PG8_STAGE(bufoff, gbase, voff) do { _Pragma("unroll") for (int _i = 0; _i < 2; ++_i) \
        __builtin_amdgcn_global_load_lds((const unsigned*)((const char*)(gbase) + (voff)[_i]), (LAS unsigned*)(lds + (bufoff) + ldsw + _i * 8192), 16, 0, 0); } while (0)
#define PG8_LDA(dst, b, h) do { _Pragma("unroll") for (int m = 0; m < 4; ++m) _Pragma("unroll") for (int k = 0; k < 2; ++k) dst[m][k] = *(const LAS bf16x8*)(lds + PG8_SA(b, h) + aoff + m * 2048 + k * 1024); } while (0)
#define PG8_LDB(dst, b, h) do { _Pragma("unroll") for (int n = 0; n < 2; ++n) _Pragma("unroll") for (int k = 0; k < 2; ++k) dst[n][k] = *(const LAS bf16x8*)(lds + PG8_SB(b, h) + boff + n * 2048 + k * 1024); } while (0)
#define PG8_MMA(ai, bj, At, Bt) do { __builtin_amdgcn_s_setprio(1); _Pragma("unroll") for (int m = 0; m < 4; ++m) _Pragma("unroll") for (int n = 0; n < 2; ++n) _Pragma("unroll") for (int k = 0; k < 2; ++k) \
        acc[ai][bj][m][n] = __builtin_amdgcn_mfma_f32_16x16x32_bf16(Bt[n][k], At[m][k], acc[ai][bj][m][n], 0, 0, 0); __builtin_amdgcn_s_setprio(0); } while (0)
#define PG8_WAIT_V(n) asm volatile("s_waitcnt vmcnt(" #n ")" ::: "memory")
#define PG8_WAIT_L(n) asm volatile("s_waitcnt lgkmcnt(" #n ")" ::: "memory")
#define PG8_BAR __builtin_amdgcn_s_barrier()
#define PG8_SCHED __builtin_amdgcn_sched_barrier(0)
    Unit cur, nxt; int ui = 0;
    if (!S.next(0, cur)) return;
    f32x4 acc[2][2][4][2];
    { float zf = 0.f; asm volatile("" : "+v"(zf));
#pragma unroll
    for (int a = 0; a < 2; ++a)
#pragma unroll
        for (int b = 0; b < 2; ++b)
#pragma unroll
            for (int m = 0; m < 4; ++m)
#pragma unroll
                for (int n = 0; n < 2; ++n) acc[a][b][m][n] = (f32x4){zf, zf, zf, zf}; }
    bf16x8 At[4][2], B0[2][2], B1[2][2];
    const char* cA = (const char*)g.A + (size_t)cur.pm * tstepA; const char* cB = (const char*)g.Bt + (size_t)cur.pb * tstepB;
    if constexpr (SP2) {
        PG8_STAGE(PG8_SB(0, 0), cB, voffB); PG8_STAGE(PG8_SB(0, 1), cB + hstepB, voffB); PG8_STAGE(PG8_SA(0, 0), cA, voffA); PG8_STAGE(PG8_SA(0, 1), cA + hstepA, voffA);
        if (wr == 1) PG8_BAR;
        PG8_WAIT_V(2); PG8_BAR;
        PG8_STAGE(PG8_SB(1, 0), cB + kstep, voffB); PG8_STAGE(PG8_SA(1, 0), cA + kstep, voffA); PG8_STAGE(PG8_SB(1, 1), cB + hstepB + kstep, voffB);
        PG8_WAIT_V(6); PG8_BAR;
    } else {
        PG8_STAGE(PG8_SB(0, 0), cB, voffB); PG8_STAGE(PG8_SA(0, 0), cA, voffA); PG8_STAGE(PG8_SB(0, 1), cB + hstepB, voffB); PG8_STAGE(PG8_SA(0, 1), cA + hstepA, voffA);
        if (wr == 1) PG8_BAR;
        PG8_WAIT_V(4); PG8_BAR;
        PG8_STAGE(PG8_SB(1, 0), cB + kstep, voffB); PG8_STAGE(PG8_SA(1, 0), cA + kstep, voffA); PG8_STAGE(PG8_SB(1, 1), cB + hstepB + kstep, voffB);
        PG8_WAIT_V(6); PG8_BAR;
    }
    for (;;) {
        const bool has_next = S.next(ui + 1, nxt);
        const char* nA = has_next ? (const char*)g.A + (size_t)nxt.pm * tstepA : cA; const char* nB = has_next ? (const char*)g.Bt + (size_t)nxt.pb * tstepB : cB;
#pragma nounroll
        for (int t = 0; t < nt; t += 2) {
            const bool last = (t == nt - 2);
            const char* a1 = cA + (size_t)(t + 1) * kstep;
            const char* a2 = last ? nA : cA + (size_t)(t + 2) * kstep; const char* b2 = last ? nB : cB + (size_t)(t + 2) * kstep;
            const char* a3 = a2 + kstep; const char* b3 = b2 + kstep;
            if constexpr (SP2) {
            PG8_LDB(B0, 0, 0); PG8_LDB(B1, 0, 1); PG8_SCHED; PG8_LDA(At, 0, 0); PG8_STAGE(PG8_SA(1, 1), a1 + hstepA, voffA);
            PG8_WAIT_V(8); PG8_WAIT_L(0); PG8_BAR; PG8_MMA(0, 0, At, B0); PG8_MMA(0, 1, At, B1); PG8_BAR; PG8_SCHED;
            PG8_LDA(At, 0, 1); PG8_STAGE(PG8_SB(0, 0), b2, voffB); PG8_STAGE(PG8_SB(0, 1), b2 + hstepB, voffB); PG8_STAGE(PG8_SA(0, 0), a2, voffA);
            PG8_WAIT_V(8); PG8_WAIT_L(0); PG8_BAR; PG8_MMA(1, 0, At, B0); PG8_MMA(1, 1, At, B1); PG8_BAR; PG8_SCHED;
            PG8_LDB(B0, 1, 0); PG8_LDB(B1, 1, 1); PG8_SCHED; PG8_LDA(At, 1, 0); PG8_STAGE(PG8_SA(0, 1), a2 + hstepA, voffA);
            PG8_WAIT_V(8); PG8_WAIT_L(0); PG8_BAR; PG8_MMA(0, 0, At, B0); PG8_MMA(0, 1, At, B1); PG8_BAR; PG8_SCHED;
            PG8_LDA(At, 1, 1); PG8_STAGE(PG8_SB(1, 0), b3, voffB); PG8_STAGE(PG8_SB(1, 1), b3 + hstepB, voffB); PG8_STAGE(PG8_SA(1, 0), a3, voffA);
            PG8_WAIT_V(8); PG8_WAIT_L(0); PG8_BAR; PG8_MMA(1, 0, At, B0); PG8_MMA(1, 1, At, B1); PG8_BAR; PG8_SCHED;
            } else {
            PG8_LDB(B0, 0, 0); PG8_SCHED; PG8_LDA(At, 0, 0); PG8_STAGE(PG8_SA(1, 1), a1 + hstepA, voffA);
            PG8_WAIT_L(8); PG8_BAR; PG8_WAIT_L(0); PG8_MMA(0, 0, At, B0); PG8_BAR; PG8_SCHED;
            PG8_LDB(B1, 0, 1); PG8_STAGE(PG8_SB(0, 0), b2, voffB);
            PG8_BAR; PG8_WAIT_L(0); PG8_MMA(0, 1, At, B1); PG8_BAR;
            PG8_LDA(At, 0, 1); PG8_STAGE(PG8_SA(0, 0), a2, voffA);
            PG8_BAR; PG8_WAIT_L(0); PG8_MMA(1, 0, At, B0); PG8_BAR; PG8_SCHED;
            PG8_STAGE(PG8_SB(0, 1), b2 + hstepB, voffB);
            PG8_WAIT_V(6); PG8_BAR; PG8_MMA(1, 1, At, B1); PG8_BAR;
            PG8_LDB(B0, 1, 0); PG8_SCHED; PG8_LDA(At, 1, 0); PG8_STAGE(PG8_SA(0, 1), a2 + hstepA, voffA);
            PG8_WAIT_L(8); PG8_BAR; PG8_WAIT_L(0); PG8_MMA(0, 0, At, B0); PG8_BAR; PG8_SCHED;
            PG8_LDB(B1, 1, 1); PG8_STAGE(PG8_SB(1, 0), b3, voffB);
            PG8_BAR; PG8_WAIT_L(0); PG8_MMA(0, 1, At, B1); PG8_BAR;
            PG8_LDA(At, 1, 1); PG8_STAGE(PG8_SA(1, 0), a3, voffA);
            PG8_BAR; PG8_WAIT_L(0); PG8_MMA(1, 0, At, B0); PG8_BAR; PG8_SCHED;
            PG8_STAGE(PG8_SB(1, 1), b3 + hstepB, voffB);
            PG8_WAIT_V(6); PG8_BAR; PG8_MMA(1, 1, At, B1); PG8_BAR;
            }
        }
        if constexpr (ALIGN_EPI) { if (wr == 0) PG8_BAR; }
        E(acc, cur, wr, wc, fr, fq);
        if (!has_next) break;
        { float zf = 0.f; asm volatile("" : "+v"(zf));
#pragma unroll
        for (int a = 0; a < 2; ++a)
#pragma unroll
            for (int b = 0; b < 2; ++b)
#pragma unroll
                for (int m = 0; m < 4; ++m)
#pragma unroll
                    for (int n = 0; n < 2; ++n) acc[a][b][m][n] = (f32x4){zf, zf, zf, zf}; }
        cur = nxt; cA = nA; cB = nB; ++ui;
        if constexpr (ALIGN_EPI) { if (wr == 1) PG8_BAR; }
    }
    PG8_WAIT_V(0);
    if constexpr (!ALIGN_EPI) { if (wr == 0) PG8_BAR; }
    PG8_BAR;
#undef PG8_SA
#undef PG8_SB
#undef PG8_STAGE
#undef PG8_LDA
#undef PG8_LDB
#undef PG8_MMA
#undef PG8_WAIT_V
#undef PG8_WAIT_L
#undef PG8_BAR
#undef PG8_SCHED
}
}

#define XB_TMO      128
#define XB_XCNT(j)  (256  + 64 * (j))
#define XB_XSUB(j)  (1280 + 64 * (j))
#define XB_XGEN(j)  (2304 + 64 * (j))
#define XB_TOP      3328
#define XB_TOPGEN   3392
#define XCD_BAR_WORDS 3456
#define XB_SPIN_CAP (1u << 18)
__device__ __forceinline__ unsigned xb_ld(unsigned* p)              { return __hip_atomic_load(p, __ATOMIC_RELAXED, __HIP_MEMORY_SCOPE_AGENT); }
__device__ __forceinline__ unsigned xb_add(unsigned* p, unsigned v) { return __hip_atomic_fetch_add(p, v, __ATOMIC_RELAXED, __HIP_MEMORY_SCOPE_AGENT); }
__device__ __forceinline__ unsigned xb_xcc_id() { return (unsigned)__builtin_amdgcn_s_getreg((3 << 11) | 20) & 0xFu; }
#define XB_SPIN(cond, bar) do { unsigned _sp = 0; while (cond) { __builtin_amdgcn_s_sleep(1); \
    if ((++_sp & 255u) == 0u) { if (xb_ld(&(bar)[XB_TMO])) break; if (_sp > XB_SPIN_CAP) { atomicAdd(&(bar)[XB_TMO], 1u); break; } } } } while (0)
struct XcdBarrier { unsigned* bar; unsigned x; volatile LAS unsigned* st; };
__device__ __forceinline__ XcdBarrier xcd_barrier_post(unsigned* bar, volatile LAS unsigned* st) {
    XcdBarrier b; b.bar = bar; b.x = xb_xcc_id(); b.st = st;
    if (threadIdx.x == 0) (void)xb_add(&bar[XB_XCNT(b.x)], 1u);
    return b;
}
__device__ __forceinline__ void xcd_barrier_complete(unsigned* bar, unsigned x, unsigned& nloc, unsigned& nx) {
    const unsigned G = gridDim.x * gridDim.y * gridDim.z;
    unsigned sum, cnt, mine, sp = 0u;
    for (;;) {
        sum = 0u; cnt = 0u; mine = 0u;
#pragma unroll
        for (unsigned j = 0; j < 16; ++j) { const unsigned c = xb_ld(&bar[XB_XCNT(j)]); sum += c; cnt += (c > 0u) ? 1u : 0u; mine = (j == x) ? c : mine; }
        if (sum == G) break;
        __builtin_amdgcn_s_sleep(1);
        if ((++sp & 255u) == 0u) { if (xb_ld(&bar[XB_TMO])) break; if (sp > XB_SPIN_CAP) { atomicAdd(&bar[XB_TMO], 1u); break; } }
    }
    nloc = mine > 0u ? mine : 1u; nx = cnt > 0u ? cnt : 1u;
}
__device__ __forceinline__ void xcd_barrier(const XcdBarrier& b, bool leader) {
    asm volatile("s_waitcnt vmcnt(0)" ::: "memory");
    __syncthreads();
    if (leader) {
        unsigned* bar = b.bar;
        __builtin_amdgcn_s_waitcnt(0);
        unsigned nloc = b.st[0], nx = b.st[1];
        if (nloc == 0u) { xcd_barrier_complete(bar, b.x, nloc, nx); b.st[0] = nloc; b.st[1] = nx; }
        const unsigned old = xb_add(&bar[XB_XSUB(b.x)], 1u);
        const unsigned gen = old / nloc;
        if (old + 1u == (gen + 1u) * nloc) {
            __builtin_amdgcn_fence(__ATOMIC_RELEASE, "agent");
            asm volatile("s_waitcnt vmcnt(0)" ::: "memory");
            const unsigned og = xb_add(&bar[XB_TOP], 1u);
            const unsigned tg = og / nx;
            if (og + 1u == (tg + 1u) * nx) xb_add(&bar[XB_TOPGEN], 1u);
            else XB_SPIN(xb_ld(&bar[XB_TOPGEN]) == tg, bar);
            __builtin_amdgcn_fence(__ATOMIC_ACQUIRE, "agent");
            xb_add(&bar[XB_XGEN(b.x)], 1u);
            asm volatile("s_waitcnt vmcnt(0)" ::: "memory");
        } else {
            XB_SPIN(xb_ld(&bar[XB_XGEN(b.x)]) == gen, bar);
            __builtin_amdgcn_fence(__ATOMIC_ACQUIRE, "agent");
            asm volatile("s_waitcnt vmcnt(0)" ::: "memory");
        }
    }
    __syncthreads();
}

struct Frame {
    LAS unsigned char* lds;
    int tid, lane, wave, vcu; static constexpr int G = GRID;
    unsigned char* ws;
    float* out;
};
__device__ __forceinline__ const float* inp(int i) {
    const __attribute__((address_space(4))) char* kp = (const __attribute__((address_space(4))) char*)__builtin_amdgcn_kernarg_segment_ptr();
    asm volatile("" : "+s"(kp));
    return *(const float* const __attribute__((address_space(4)))*)(kp + 8 * i);
}

template <int KIND> __device__ __forceinline__ int tr_dest(int n) {
    if (KIND == 1) return n < 640 ? n : (n < 652 ? PC_GA + (n - 640) : n - 12);
    if (KIND == 2) return (n >> 7) * 256 + (n & 127);
    if (KIND == 3) return (n >> 7) * 256 + 128 + (n & 127);
    return n;
}
template <int KIND> __device__ __forceinline__ float tr_scale(int n) {
    if (KIND == 1) {
        if (n < 256) return 0.125f * LOG2E;
        if (n >= 652 && n < 908) return 0.17677669529663687f * LOG2E;
        if (n >= 1420 && n < 1932) return 0.125f * LOG2E;
    }
    return 1.0f;
}
typedef short v4i16_tt __attribute__((ext_vector_type(4)));
template <int KIND> __device__ __forceinline__ void tr_item(const float* W, int K, int N, bf16_t* WT, LAS unsigned char* scr, int item, int lane) {
    constexpr int TP = 136;
    const int nblk = (N + 63) / 64, kb = item / nblk, nb = item % nblk, k0 = 64 * kb, n0 = 64 * nb;
    const int c4 = (lane & 15) * 4, rr = lane >> 4;
    const bool inb = (n0 + c4) < N;
    f32x4 v[16];
#pragma unroll
    for (int i = 0; i < 16; ++i) v[i] = inb ? *(const f32x4*)(W + (size_t)(k0 + 4 * i + rr) * N + n0 + c4) : (f32x4){0.f, 0.f, 0.f, 0.f};
    const float s0 = tr_scale<KIND>(n0 + c4), s1 = tr_scale<KIND>(n0 + c4 + 1), s2 = tr_scale<KIND>(n0 + c4 + 2), s3 = tr_scale<KIND>(n0 + c4 + 3);
#pragma unroll
    for (int i = 0; i < 16; ++i) { u32x2 o; o.x = pk2(v[i][0] * s0, v[i][1] * s1); o.y = pk2(v[i][2] * s2, v[i][3] * s3); *(LAS u32x2*)(scr + (4 * i + rr) * TP + c4 * 2) = o; }
    LDS_WAIT(); asm volatile("" ::: "memory");
    const int g = lane >> 4, i16 = lane & 15;
#pragma unroll
    for (int r = 0; r < 8; ++r) { const int kc = (r & 1) * 4 + g, cbk = r >> 1, n = n0 + 16 * cbk + i16;
        const LAS unsigned char* p = scr + (8 * kc + (i16 >> 2)) * TP + (16 * cbk + 4 * (i16 & 3)) * 2;
        const v4i16_tt lo = __builtin_amdgcn_ds_read_tr16_b64_v4i16((LAS v4i16_tt*)p), hi = __builtin_amdgcn_ds_read_tr16_b64_v4i16((LAS v4i16_tt*)(p + 4 * TP));
        if (n < N) { u32x4 o; const u32x2 a = __builtin_bit_cast(u32x2, lo), b = __builtin_bit_cast(u32x2, hi); o.x = a.x; o.y = a.y; o.z = b.x; o.w = b.y;
            *(u32x4*)(WT + (size_t)tr_dest<KIND>(n) * K + k0 + 8 * kc) = o; } }
    LDS_WAIT(); asm volatile("" ::: "memory");
}
__device__ __forceinline__ void cvt_rows(const float* src, bf16_t* dst, size_t n8, size_t g, size_t ng) {
    for (size_t i = g; i < n8; i += ng) { const f32x4 a = *(const f32x4*)(src + i * 8), b = *(const f32x4*)(src + i * 8 + 4);
        u32x4 o; o.x = pk2(a[0], a[1]); o.y = pk2(a[2], a[3]); o.z = pk2(b[0], b[1]); o.w = pk2(b[2], b[3]); *(u32x4*)(dst + i * 8) = o; }
}
__device__ __forceinline__ void p0_prologue(Frame& F) {
    LAS unsigned char* scr = F.lds + F.wave * 16384;
    const int gw = F.vcu * NWAVES + F.wave, NGW = F.G * NWAVES, lane = F.lane;
    unsigned char* ws = F.ws;
    constexpr int I_WIN = 16 * 35, I_WOUT = 16 * 16, I_FG = 16 * 44, I_FD = 44 * 16, I_PG = 16 * 16, I_PP = 4 * 16, I_C1 = 32 * 2, I_C2 = 2 * 1, I_MG = 16 * 56, I_MD = 56 * 16;
    constexpr int N0 = 2 * I_WIN, N1 = N0 + 2 * I_WOUT, N2 = N1 + 2 * I_FG, N3 = N2 + I_FD, N4 = N3 + 2 * I_PG, N5 = N4 + 2 * I_PP, N6 = N5 + 4 * I_C1, N7 = N6 + 4 * I_C2,
                  N8 = N7 + 16 * I_MG, N9 = N8 + 8 * I_MD;
    for (int it = gw; it < N9; it += NGW) {
        int r = it;
        if (r < N0) { const int l = r / I_WIN; r -= l * I_WIN; tr_item<1>(inp(2) + (size_t)l * D * NPROJ, D, NPROJ, (bf16_t*)(ws + (l ? WS_WIN1 : WS_WIN0)), scr, r, lane); continue; }
        if (r < N1) { r -= N0; const int l = r / I_WOUT; r -= l * I_WOUT; tr_item<0>(inp(9) + (size_t)l * D * D, D, D, (bf16_t*)(ws + (l ? WS_WOUT1 : WS_WOUT0)), scr, r, lane); continue; }
        if (r < N2) { r -= N1; const int l = r / I_FG; r -= l * I_FG; if (l == 0) tr_item<2>(inp(12), D, FF, (bf16_t*)(ws + WS_FGU), scr, r, lane); else tr_item<3>(inp(13), D, FF, (bf16_t*)(ws + WS_FGU), scr, r, lane); continue; }
        if (r < N3) { r -= N2; tr_item<0>(inp(14), FF, D, (bf16_t*)(ws + WS_FD), scr, r, lane); continue; }
        if (r < N4) { r -= N3; const int l = r / I_PG; r -= l * I_PG; tr_item<0>(inp(21) + (size_t)l * D * D, D, D, (bf16_t*)(ws + (l ? WS_PLEG1 : WS_PLEG0)), scr, r, lane); continue; }
        if (r < N5) { r -= N4; const int l = r / I_PP; r -= l * I_PP; tr_item<0>(inp(22) + (size_t)l * PLE * D, PLE, D, (bf16_t*)(ws + (l ? WS_PLEP1 : WS_PLEP0)), scr, r, lane); continue; }
        if (r < N6) { r -= N5; const int q = r / I_C1; r -= q * I_C1;
            tr_item<0>(inp(4) + (size_t)q * 2048 * 128, 2048, 128, (bf16_t*)(ws + ((q >> 1) ? WS_CW1_1 : WS_CW1_0)) + (size_t)(q & 1) * 128 * 2048, scr, r, lane); continue; }
        if (r < N7) { r -= N6; const int q = r / I_C2; r -= q * I_C2;
            tr_item<0>(inp(5) + (size_t)q * 128 * 64, 128, 64, (bf16_t*)(ws + WS_TAB + TB_CW2) + (size_t)q * 64 * 128, scr, r, lane); continue; }
        if (r < N8) { r -= N7; const int q = r / I_MG; r -= q * I_MG; const int e = q >> 1;
            if ((q & 1) == 0) tr_item<2>(inp(16) + (size_t)e * D * FE, D, FE, (bf16_t*)(ws + WS_MOE_GU) + (size_t)e * 2 * FE * D, scr, r, lane);
            else tr_item<3>(inp(17) + (size_t)e * D * FE, D, FE, (bf16_t*)(ws + WS_MOE_GU) + (size_t)e * 2 * FE * D, scr, r, lane); continue; }
        { r -= N8; const int e = r / I_MD; r -= e * I_MD; tr_item<0>(inp(18) + (size_t)e * FE * D, FE, D, (bf16_t*)(ws + WS_MOE_D) + (size_t)e * D * FE, scr, r, lane); }
    }
    { const size_t g = (size_t)blockIdx.x * NTHREADS + F.tid, ng = (size_t)F.G * NTHREADS; const size_t n16 = (size_t)(NPP - NPROJ) * D * 2 / 16;
      unsigned zz = 0u; asm volatile("" : "+v"(zz));
      for (size_t i = g; i < 2 * n16; i += ng) { const int l = i >= n16; const size_t j = i - (l ? n16 : 0); *(u32x4*)(ws + (l ? WS_WIN1 : WS_WIN0) + (size_t)NPROJ * D * 2 + j * 16) = (u32x4){zz, zz, zz, zz}; }
      cvt_rows(inp(0), (bf16_t*)(ws + WS_XB), (size_t)M * D / 8, g, ng); }
    for (int u = gw; u < 4 * 128; u += NGW) { const int q = u >> 7, n = u & 127; const float* pos = inp(3) + (size_t)q * 2048; const float* w1 = inp(4) + (size_t)q * 2048 * 128 + n;
        float s = 0.f; for (int k = lane; k < 2048; k += 64) s += pos[k] * w1[(size_t)k * 128]; s = wave_sum(s);
        if (lane == 0) ((float*)(ws + WS_TAB + TB_CBIAS))[u] = s; }
}

namespace at {
typedef short v4i16_t __attribute__((ext_vector_type(4)));
__device__ __forceinline__ s16x4 vtr(const LAS char* p) { return __builtin_bit_cast(s16x4, __builtin_amdgcn_ds_read_tr16_b64_v4i16((LAS v4i16_t*)p)); }
__device__ __forceinline__ void glds16(const void* g, LAS void* l) { __builtin_amdgcn_global_load_lds((const unsigned*)g, (LAS unsigned*)l, 16, 0, 0); }
struct Acc { f32x16 o0, o1; float m, l; };
__device__ __forceinline__ void acc_init(Acc& a) {
#pragma unroll
    for (int r = 0; r < 16; ++r) { a.o0[r] = 0.f; a.o1[r] = 0.f; }
    a.m = NEGBIG; a.l = 0.f;
}
__device__ __forceinline__ float fadd_(float a, float b) { float r; asm("v_add_f32_e32 %0, %1, %2" : "=v"(r) : "v"(a), "v"(b)); return r; }
__device__ __forceinline__ float fsub_(float a, float b) { float r; asm("v_sub_f32_e32 %0, %1, %2" : "=v"(r) : "v"(a), "v"(b)); return r; }
__device__ __forceinline__ float fmul_(float a, float b) { float r; asm("v_mul_f32_e32 %0, %1, %2" : "=v"(r) : "v"(a), "v"(b)); return r; }
template <int NG> __device__ __forceinline__ void dma_kv(const bf16_t* Kp, const bf16_t* Vp, int pitch, int kv0, LAS char* kslot, LAS char* vslot, int gw, int lane) {
#pragma unroll
    for (int pc = gw; pc < 8; pc += NG) {
        glds16(Kp + (size_t)(kv0 + lane) * pitch + pc * 8, kslot + pc * 1024);
        glds16(Vp + (size_t)(kv0 + 16 * (pc & 3) + (lane >> 2)) * pitch + (pc >> 2) * 32 + (lane & 3) * 8, vslot + pc * 1024);
    }
}
template <int D0A, int D0B, int STEP> __device__ __forceinline__ void score_tile(f32x16& p0, f32x16& p1, const LAS char* kslot, const bf16x8* qr, int dq, unsigned W, float slope2, float ref, int r32, int hi) {
    asm volatile("" : "+v"(slope2));
    const float fb = -slope2 * (float)dq - ref;
#pragma unroll
    for (int r = 0; r < 16; ++r) { const int off = STEP * ((r & 3) + 8 * (r >> 2)); p0[r] = __builtin_fmaf(slope2, (float)off, fb); p1[r] = __builtin_fmaf(slope2, (float)(off + 32 * STEP), fb); }
    const LAS char* kb = kslot + hi * 1024 + r32 * 16;
#pragma unroll
    for (int d0 = D0A; d0 < D0B; ++d0) {
        const bf16x8 b0 = *(const LAS bf16x8*)(kb + d0 * 2048), b1 = *(const LAS bf16x8*)(kb + d0 * 2048 + 512);
        p0 = __builtin_amdgcn_mfma_f32_32x32x16_bf16(b0, qr[d0], p0, 0, 0, 0);
        p1 = __builtin_amdgcn_mfma_f32_32x32x16_bf16(b1, qr[d0], p1, 0, 0, 0);
    }
    const bool allv = (dq >= 59 * STEP) && ((unsigned)dq < W);
    if (!__all(allv)) {
#pragma unroll
        for (int r = 0; r < 16; ++r) { const int off = STEP * ((r & 3) + 8 * (r >> 2));
            if ((unsigned)(dq - off) >= W) p0[r] = NEGBIG;
            if ((unsigned)(dq - off - 32 * STEP) >= W) p1[r] = NEGBIG; }
    }
}
constexpr float SM_THR = 8.0f;
__device__ __forceinline__ float acc_ref(const Acc& a) { return a.m > -1e29f ? a.m : 0.f; }
__device__ __forceinline__ void softmax_pv(Acc& a, f32x16& p0, f32x16& p1, const LAS char* vlane) {
    float r0 = fmaxf(p0[0], p1[0]), r1 = fmaxf(p0[1], p1[1]);
#pragma unroll
    for (int r = 2; r < 16; r += 2) { r0 = fmaxf(fmaxf(r0, p0[r]), p1[r]); r1 = fmaxf(fmaxf(r1, p0[r + 1]), p1[r + 1]); }
    float rm = fmaxf(r0, r1);
    rm = fmaxf(rm, __shfl_xor(rm, 32));
    const bool started = a.m > -1e29f;
    const bool need = started ? (rm > SM_THR) : (rm > -1e29f);
    if (__any(need)) {
        const float dl = need ? rm : 0.f, f = (need && started) ? fexp2(-dl) : 1.0f;
        a.m = need ? (started ? a.m + dl : dl) : a.m;
        a.l *= f;
#pragma unroll
        for (int r = 0; r < 16; ++r) { p0[r] -= dl; p1[r] -= dl; a.o0[r] *= f; a.o1[r] *= f; }
    }
    float s0 = 0.f, s1 = 0.f;
#pragma unroll
    for (int r = 0; r < 16; r += 2) { p0[r] = fexp2(p0[r]); p0[r + 1] = fexp2(p0[r + 1]); p1[r] = fexp2(p1[r]); p1[r + 1] = fexp2(p1[r + 1]); s0 += p0[r] + p1[r]; s1 += p0[r + 1] + p1[r + 1]; }
    a.l += s0 + s1;
    u32x4 w0, w1, w2, w3;
    w0.x = cvt_pk_bf16(p0[0], p0[1]); w0.y = cvt_pk_bf16(p0[2], p0[3]); w0.z = cvt_pk_bf16(p0[4], p0[5]); w0.w = cvt_pk_bf16(p0[6], p0[7]);
    w1.x = cvt_pk_bf16(p0[8], p0[9]); w1.y = cvt_pk_bf16(p0[10], p0[11]); w1.z = cvt_pk_bf16(p0[12], p0[13]); w1.w = cvt_pk_bf16(p0[14], p0[15]);
    w2.x = cvt_pk_bf16(p1[0], p1[1]); w2.y = cvt_pk_bf16(p1[2], p1[3]); w2.z = cvt_pk_bf16(p1[4], p1[5]); w2.w = cvt_pk_bf16(p1[6], p1[7]);
    w3.x = cvt_pk_bf16(p1[8], p1[9]); w3.y = cvt_pk_bf16(p1[10], p1[11]); w3.z = cvt_pk_bf16(p1[12], p1[13]); w3.w = cvt_pk_bf16(p1[14], p1[15]);
    const bf16x8 pw[4] = {__builtin_bit_cast(bf16x8, w0), __builtin_bit_cast(bf16x8, w1), __builtin_bit_cast(bf16x8, w2), __builtin_bit_cast(bf16x8, w3)};
#define AT_VRD(L0, H0, L1, H1, S) do { \
        asm volatile("ds_read_b64_tr_b16 %0, %1 offset:%2" : "=v"(L0) : "v"(vaddr), "i"((S) * 1024) : "memory"); \
        asm volatile("ds_read_b64_tr_b16 %0, %1 offset:%2" : "=v"(H0) : "v"(vaddr), "i"((S) * 1024 + 512) : "memory"); \
        asm volatile("ds_read_b64_tr_b16 %0, %1 offset:%2" : "=v"(L1) : "v"(vaddr), "i"(4096 + (S) * 1024) : "memory"); \
        asm volatile("ds_read_b64_tr_b16 %0, %1 offset:%2" : "=v"(H1) : "v"(vaddr), "i"(4096 + (S) * 1024 + 512) : "memory"); } while (0)
    const unsigned vaddr = (unsigned)(uintptr_t)vlane;
    s16x4 la0, ha0, la1, ha1, lb0, hb0, lb1, hb1;
    AT_VRD(la0, ha0, la1, ha1, 0);
#pragma unroll
    for (int s = 0; s < 4; ++s) {
        if (s & 1) { if (s < 3) AT_VRD(la0, ha0, la1, ha1, s + 1); } else { AT_VRD(lb0, hb0, lb1, hb1, s + 1); }
        if (s & 1) {
            if (s < 3) asm volatile("s_waitcnt lgkmcnt(4)" : "+v"(lb0), "+v"(hb0), "+v"(lb1), "+v"(hb1) :: "memory"); else asm volatile("s_waitcnt lgkmcnt(0)" : "+v"(lb0), "+v"(hb0), "+v"(lb1), "+v"(hb1) :: "memory");
            const bf16x8 v0 = {lb0[0], lb0[1], lb0[2], lb0[3], hb0[0], hb0[1], hb0[2], hb0[3]}, v1 = {lb1[0], lb1[1], lb1[2], lb1[3], hb1[0], hb1[1], hb1[2], hb1[3]};
            a.o0 = __builtin_amdgcn_mfma_f32_32x32x16_bf16(v0, pw[s], a.o0, 0, 0, 0); a.o1 = __builtin_amdgcn_mfma_f32_32x32x16_bf16(v1, pw[s], a.o1, 0, 0, 0);
        } else {
            asm volatile("s_waitcnt lgkmcnt(4)" : "+v"(la0), "+v"(ha0), "+v"(la1), "+v"(ha1) :: "memory");
            const bf16x8 v0 = {la0[0], la0[1], la0[2], la0[3], ha0[0], ha0[1], ha0[2], ha0[3]}, v1 = {la1[0], la1[1], la1[2], la1[3], ha1[0], ha1[1], ha1[2], ha1[3]};
            a.o0 = __builtin_amdgcn_mfma_f32_32x32x16_bf16(v0, pw[s], a.o0, 0, 0, 0); a.o1 = __builtin_amdgcn_mfma_f32_32x32x16_bf16(v1, pw[s], a.o1, 0, 0, 0);
        }
    }
#undef AT_VRD
}
__device__ __forceinline__ int vlane_off(int lane) { const int hi = lane >> 5; return ((lane >> 4) & 1) * 32 + (lane & 3) * 8 + (4 * hi + ((lane & 15) >> 2)) * 64; }
__device__ __forceinline__ void load_q(bf16x8* qr, const bf16_t* qrow, int hi) {
#pragma unroll
    for (int d0 = 0; d0 < 4; ++d0) qr[d0] = *(const bf16x8*)(qrow + d0 * 16 + hi * 8);
}
struct RangeIt { int t, end; __device__ __forceinline__ bool next(int& k) { if (t >= end) return false; k = t++; return true; } };
struct BitsIt { unsigned long long U; __device__ __forceinline__ bool next(int& k) { if (!U) return false; k = __builtin_ctzll(U); U &= U - 1ull; return true; } };
struct DqCausal { int t4; __device__ __forceinline__ int operator()(int kvt) const { return t4 - 64 * kvt; } };
struct DqCmp { int t4; __device__ __forceinline__ int operator()(int kvt) const { return t4 - 1024 * kvt; } };
struct DqSel { int t4; unsigned long long mask; __device__ __forceinline__ int operator()(int kvt) const { return ((mask >> kvt) & 1ull) ? t4 - 64 * kvt : -1000000; } };

template <int NMAP, int STEP, int NG, class It, class Dq>
__device__ __forceinline__ void flash_stage(Acc* a, const bf16x8* qr, const bf16_t* Kp, const bf16_t* Vp, int pitch, It it, const Dq dqf, unsigned W, float slope2, LAS char* slots, int gw, int lane_) {
    int lane = lane_; asm volatile("" : "+v"(lane));
    const int r32 = lane & 31, hi = lane >> 5, vlo = vlane_off(lane);
    constexpr int G = 16 / NG;
    int c0 = 0, c1 = 0, c2 = 0; bool h0 = it.next(c0); bool h1 = h0 && it.next(c1);
    if (h0) dma_kv<NG>(Kp, Vp, pitch, 64 * c0, slots, slots + 8192, gw, lane);
    if (h1) dma_kv<NG>(Kp, Vp, pitch, 64 * c1, slots + 16384, slots + 16384 + 8192, gw, lane);
    int s = 0;
    while (h0) {
        const bool h2 = h1 && it.next(c2);
        if (h1) { if (G == 2) asm volatile("s_waitcnt vmcnt(2)" ::: "memory"); else asm volatile("s_waitcnt vmcnt(4)" ::: "memory"); } else VM_WAIT();
        LDS_WAIT(); __builtin_amdgcn_s_barrier(); asm volatile("" ::: "memory");
        const int s2 = s >= 1 ? s - 1 : 2;
        if (h2) dma_kv<NG>(Kp, Vp, pitch, 64 * c2, slots + s2 * 16384, slots + s2 * 16384 + 8192, gw, lane);
        const LAS char* ks = slots + s * 16384; const LAS char* vl = ks + 8192 + vlo;
        const int dq = dqf(c0);
        f32x16 p0, p1;
        if (NMAP == 1) { score_tile<0, 4, STEP>(p0, p1, ks, qr, dq, W, slope2, acc_ref(a[0]), r32, hi); softmax_pv(a[0], p0, p1, vl); }
        else { score_tile<0, 2, STEP>(p0, p1, ks, qr, dq, W, slope2, acc_ref(a[0]), r32, hi); softmax_pv(a[0], p0, p1, vl);
               score_tile<2, 4, STEP>(p0, p1, ks, qr, dq, W, slope2, acc_ref(a[NMAP - 1]), r32, hi); softmax_pv(a[NMAP - 1], p0, p1, vl); }
        c0 = c1; c1 = c2; h0 = h1; h1 = h2; s = s == 2 ? 0 : s + 1;
    }
    LDS_WAIT(); __builtin_amdgcn_s_barrier(); asm volatile("" ::: "memory");
}
__device__ __forceinline__ void store_ot(bf16_t* orow, const f32x16& o0, const f32x16& o1, int hi) {
#pragma unroll
    for (int g = 0; g < 4; ++g) {
        u32x2 w; w.x = cvt_pk_bf16(o0[4 * g], o0[4 * g + 1]); w.y = cvt_pk_bf16(o0[4 * g + 2], o0[4 * g + 3]); *(u32x2*)(orow + 8 * g + 4 * hi) = w;
        u32x2 v; v.x = cvt_pk_bf16(o1[4 * g], o1[4 * g + 1]); v.y = cvt_pk_bf16(o1[4 * g + 2], o1[4 * g + 3]); *(u32x2*)(orow + 32 + 8 * g + 4 * hi) = v;
    }
}
}

__device__ __forceinline__ bf16_t* ws_bf(Frame& F, size_t off) { return (bf16_t*)(F.ws + off); }

__device__ __forceinline__ void diff_unit(Frame& F, int layer, int b, int h, int qb, float lam, float post) {
    using namespace at;
    const int w = F.wave, lane = F.lane, half = w >> 2, wq = w & 3, r32 = lane & 31, hi = lane >> 5;
    const int t = qb * 128 + 32 * wq + r32; const size_t row = (size_t)b * SEQ + t;
    const bf16_t* PROJ = ws_bf(F, WS_PROJ);
    bf16x8 qr[4]; load_q(qr, PROJ + row * NPP + PC_QB + h * 64, hi);
    Acc a[2]; acc_init(a[0]); acc_init(a[1]);
    const float slope2 = fexp2(-(float)(5 + h)) * LOG2E;
    const bf16_t* Kp = PROJ + (size_t)b * SEQ * NPP + PC_KB + h * 64; const bf16_t* Vp = PROJ + (size_t)b * SEQ * NPP + PC_VB + h * 64;
    const int n = qb + 1;
    LAS char* slots = (LAS char*)F.lds + half * 49152;
    flash_stage<2, 1, 4>(a, qr, Kp, Vp, NPP, RangeIt{half * n, (half + 1) * n}, DqCausal{t - 4 * hi}, 0x7fffffffu, slope2, slots, wq, lane);
    a[0].l += __shfl_xor(a[0].l, 32); a[1].l += __shfl_xor(a[1].l, 32);
    LAS float* mb = (LAS float*)F.lds + (size_t)wq * (2 * 34 * 64) + lane;
    if (half == 1) {
#pragma unroll
        for (int c = 0; c < 2; ++c) { LAS float* p = mb + c * 34 * 64;
#pragma unroll
            for (int r = 0; r < 16; ++r) { p[r * 64] = a[c].o0[r]; p[(16 + r) * 64] = a[c].o1[r]; }
            p[32 * 64] = a[c].m; p[33 * 64] = a[c].l; }
    }
    LDS_WAIT(); __syncthreads();
    if (half == 0) {
        f32x16 o0, o1;
#pragma unroll
        for (int c = 0; c < 2; ++c) { const LAS float* p = mb + c * 34 * 64;
            const float mb_ = p[32 * 64], lb = p[33 * 64], mt = fmaxf(a[c].m, mb_), fa = fexp2(a[c].m - mt), fbb = fexp2(mb_ - mt);
            const float l = a[c].l * fa + lb * fbb, inv = frcp(l), ca = fa * inv * (c ? -lam : 1.0f), cb = fbb * inv * (c ? -lam : 1.0f);
#pragma unroll
            for (int r = 0; r < 16; ++r) { const float x0 = a[c].o0[r] * ca + p[r * 64] * cb, x1 = a[c].o1[r] * ca + p[(16 + r) * 64] * cb;
                if (c == 0) { o0[r] = x0; o1[r] = x1; } else { o0[r] += x0; o1[r] += x1; } } }
        float ss = 0.f;
#pragma unroll
        for (int r = 0; r < 16; ++r) ss += o0[r] * o0[r] + o1[r] * o1[r];
        ss += __shfl_xor(ss, 32);
        const float rs = __builtin_amdgcn_rsqf(ss * (1.0f / 64.0f) + LN_EPS) * post;
        const float* sub = inp(7) + layer * 64;
#pragma unroll
        for (int g = 0; g < 4; ++g) { const f32x4 s0 = *(const f32x4*)(sub + 8 * g + 4 * hi), s1 = *(const f32x4*)(sub + 32 + 8 * g + 4 * hi);
#pragma unroll
            for (int k = 0; k < 4; ++k) { o0[4 * g + k] *= rs * s0[k]; o1[4 * g + k] *= rs * s1[k]; } }
        store_ot(ws_bf(F, WS_AO) + row * D + 256 + h * 64, o0, o1, hi);
    }
    __syncthreads();
}
__device__ __forceinline__ void swa_unit(Frame& F, int layer, int b, int kvh, int qblk) {
    using namespace at;
    const int w = F.wave, lane = F.lane, r32 = lane & 31, hi = lane >> 5, hd = kvh * 4 + (w >> 1);
    const int t = qblk * 64 + 32 * (w & 1) + r32; const size_t row = (size_t)b * SEQ + t;
    const bf16_t* PROJ = ws_bf(F, WS_PROJ);
    bf16x8 qr[4]; load_q(qr, PROJ + row * NPP + PC_QC + hd * 64, hi);
    Acc a; acc_init(a);
    const float slope2 = fexp2(-0.5f * (float)(hd + 1)) * LOG2E;
    const bf16_t* Kp = PROJ + (size_t)b * SEQ * NPP + PC_KC + kvh * 64; const bf16_t* Vp = PROJ + (size_t)b * SEQ * NPP + PC_VC + kvh * 64;
    flash_stage<1, 1, 8>(&a, qr, Kp, Vp, NPP, RangeIt{qblk >= 2 ? qblk - 2 : 0, qblk + 1}, DqCausal{t - 4 * hi}, 128u, slope2, (LAS char*)F.lds, w, lane);
    const float l = a.l + __shfl_xor(a.l, 32), sink2 = inp(8)[layer * 8 + hd] * LOG2E, mt = fmaxf(a.m, sink2), sc = fexp2(a.m - mt), f = sc * frcp(l * sc + fexp2(sink2 - mt));
#pragma unroll
    for (int r = 0; r < 16; ++r) { a.o0[r] *= f; a.o1[r] *= f; }
    store_ot(ws_bf(F, WS_AO) + row * D + 512 + hd * 64, a.o0, a.o1, hi);
}
__device__ __forceinline__ void compress_unit(Frame& F, int layer, int kv, int b, int grp) {
    const int w = F.wave, lane = F.lane, i0 = 16 * grp, q = layer * 2 + kv;
    const bf16_t* PROJ = ws_bf(F, WS_PROJ);
    const bf16_t* w1t = ws_bf(F, layer ? WS_CW1_1 : WS_CW1_0) + (size_t)kv * 128 * 2048;
    const bf16_t* w2t = (const bf16_t*)(F.ws + WS_TAB + TB_CW2) + (size_t)q * 64 * 128;
    const float* cb = (const float*)(F.ws + WS_TAB + TB_CBIAS) + q * 128;
    LAS float* PS = (LAS float*)F.lds;
    LAS bf16_t* H1 = (LAS bf16_t*)(F.lds + 8 * 16 * 132 * 4);
    f32x4 acc[8];
#pragma unroll
    for (int n = 0; n < 8; ++n) acc[n] = (f32x4){0.f, 0.f, 0.f, 0.f};
    const bf16_t* ap = PROJ + ((size_t)b * SEQ + 16 * (i0 + (lane & 15)) + 4 * w) * NPP + PC_KVA + kv * 64 + 8 * (lane >> 4);
    const bf16_t* bp = w1t + (size_t)(lane & 15) * 2048 + 256 * w + 8 * (lane >> 4);
    bf16x8 A[8];
#pragma unroll
    for (int ks = 0; ks < 8; ++ks) A[ks] = *(const bf16x8*)(ap + (size_t)(ks >> 1) * NPP + (ks & 1) * 32);
#pragma unroll
    for (int ks = 0; ks < 8; ++ks) {
#pragma unroll
        for (int n = 0; n < 8; ++n) { const bf16x8 B = *(const bf16x8*)(bp + (size_t)n * 16 * 2048 + ks * 32); acc[n] = __builtin_amdgcn_mfma_f32_16x16x32_bf16(A[ks], B, acc[n], 0, 0, 0); } }
#pragma unroll
    for (int n = 0; n < 8; ++n)
#pragma unroll
        for (int r = 0; r < 4; ++r) PS[(w * 16 + 4 * (lane >> 4) + r) * 132 + 16 * n + (lane & 15)] = acc[n][r];
    LDS_WAIT(); __syncthreads();
    { const int row = F.tid >> 5, c0 = 4 * (F.tid & 31); f32x4 sum = *(const LAS f32x4*)(PS + row * 132 + c0);
#pragma unroll
      for (int ww = 1; ww < 8; ++ww) sum += *(const LAS f32x4*)(PS + (ww * 16 + row) * 132 + c0);
      const f32x4 bias = *(const f32x4*)(cb + c0);
#pragma unroll
      for (int j = 0; j < 4; ++j) { const float x = sum[j] + bias[j]; const float u = 0.7978845608028654f * (x + 0.044715f * x * x * x);
          const float th = 1.0f - 2.0f * frcp(1.0f + fexp2(2.0f * LOG2E * u)); H1[row * 136 + c0 + j] = (bf16_t)f2bf(0.5f * x * (1.0f + th)); } }
    LDS_WAIT(); __syncthreads();
    if (w < 4) { f32x4 acc2 = {0.f, 0.f, 0.f, 0.f};
#pragma unroll
      for (int ks = 0; ks < 4; ++ks) { const bf16x8 A2 = *(const LAS bf16x8*)(H1 + (lane & 15) * 136 + 32 * ks + 8 * (lane >> 4));
          const bf16x8 B2 = *(const bf16x8*)(w2t + (size_t)(16 * w + (lane & 15)) * 128 + 32 * ks + 8 * (lane >> 4));
          acc2 = __builtin_amdgcn_mfma_f32_16x16x32_bf16(A2, B2, acc2, 0, 0, 0); }
      bf16_t* dst = ws_bf(F, WS_KCV) + (size_t)kv * BATCH * 256 * 64 + (size_t)b * 256 * 64;
#pragma unroll
      for (int r = 0; r < 4; ++r) { const int i = i0 + 4 * (lane >> 4) + r; dst[(size_t)i * 64 + 16 * w + (lane & 15)] = (i == 255) ? (bf16_t)0 : (bf16_t)f2bf(acc2[r]); } }
    __syncthreads();
}
__device__ __forceinline__ void nsa_unit(Frame& F, int layer, int b, int qblk) {
    using namespace at;
    int lane = F.lane; asm volatile("" : "+v"(lane));
    const int w = F.wave, r32 = lane & 31, hi = lane >> 5, h = w >> 1, ql = 32 * (w & 1) + r32, q0 = qblk * 64;
    const int t = q0 + ql; const size_t row = (size_t)b * SEQ + t;
    const bf16_t* PROJ = ws_bf(F, WS_PROJ);
    LAS char* slots = (LAS char*)F.lds;
    LAS float* impL = (LAS float*)(F.lds + 49152);
    LAS unsigned long long* selm = (LAS unsigned long long*)(F.lds + 49152 + 4 * 64 * 65 * 4);
    bf16x8 qr[4]; load_q(qr, PROJ + row * NPP + PC_QA + h * 64, hi);
    const float slope2 = fexp2(-0.5f * (float)(9 + 2 * h)) * LOG2E;
#define NSA_GATE(i) sigmoidf_(bf2f(PROJ[row * NPP + PC_GA + h * 3 + (i)]))
    f32x16 out0, out1;
    const bf16_t* KC = ws_bf(F, WS_KCV) + (size_t)b * 256 * 64; const bf16_t* VC = KC + (size_t)BATCH * 256 * 64;
    const int nblk = (q0 / 16 + 3) < 255 ? (q0 / 16 + 3) : 255, ntile = (nblk + 63) >> 6;
    float mfin, inv;
    { Acc a; acc_init(a);
      flash_stage<1, 16, 8>(&a, qr, KC, VC, 64, RangeIt{0, ntile}, DqCmp{t - 31 - 64 * hi}, 0x7fffffffu, slope2, slots, w, lane);
      const float l = a.l + __shfl_xor(a.l, 32); inv = l > 0.f ? frcp(l) : 0.f; mfin = a.m;
      const float c = NSA_GATE(0) * inv;
#pragma unroll
      for (int r = 0; r < 16; ++r) { out0[r] = a.o0[r] * c; out1[r] = a.o1[r] * c; } }
    { float vprev = 0.f; int s = 0; int lane = F.lane; asm volatile("" : "+v"(lane)); const int r32 = lane & 31, hi = lane >> 5, ql = 32 * (w & 1) + r32;
      dma_kv<8>(KC, VC, 64, 0, slots, slots + 8192, w, lane);
      for (int kt = 0; kt < ntile; ++kt) {
          VM_WAIT(); __syncthreads();
          if (kt + 1 < ntile) dma_kv<8>(KC, VC, 64, 64 * (kt + 1), slots + (s ^ 1) * 16384, slots + (s ^ 1) * 16384 + 8192, w, lane);
          f32x16 p0, p1; score_tile<0, 4, 16>(p0, p1, slots + s * 16384, qr, t - 31 - 64 * hi - 1024 * kt, 0x7fffffffu, slope2, 0.f, r32, hi);
          LAS float* ip = impL + (size_t)(h * 64 + ql) * 65 + 16 * kt + hi;
#pragma unroll
          for (int ph = 0; ph < 2; ++ph)
#pragma unroll
              for (int g = 0; g < 4; ++g) { float x[4];
#pragma unroll
                  for (int k = 0; k < 4; ++k) { const float sv = ph ? p1[4 * g + k] : p0[4 * g + k]; x[k] = sv > -1e29f ? fexp2(sv - mfin) * inv : 0.f; }
                  const float hb = 0.5f * x[3], v = __shfl_xor(hb, 32), add = hi ? v : vprev; vprev = v;
                  ip[8 * ph + 2 * g] = x[0] + x[1] + x[2] + hb + add; }
          s ^= 1; }
      LDS_WAIT(); __syncthreads(); }
    { const int tb = q0 >> 6; int ln = lane; asm volatile("" : "+v"(ln));
#pragma nounroll
      for (int i = 0; i < 8; ++i) { const int qq = 8 * w + i; const LAS float* ib = impL + (size_t)qq * 65 + ln;
          float v = ib[0] + ib[64 * 65] + ib[2 * 64 * 65] + ib[3 * 64 * 65];
          const bool forced = (ln == 0) || (ln == tb) || (ln == tb - 1), future = ln > tb;
          v = forced ? 1e9f : (future ? -1.0f : v);
          int cnt = 0;
#pragma unroll 8
          for (int jj = 0; jj < 64; ++jj) { const float vj = __builtin_bit_cast(float, __builtin_amdgcn_readlane(__builtin_bit_cast(int, v), jj)); cnt += (vj > v || (vj == v && jj < ln)) ? 1 : 0; }
          const unsigned long long mk = __ballot(cnt < 16 && !future);
          if (ln == 0) selm[qq] = mk; }
      LDS_WAIT(); __syncthreads(); }
    const bf16_t* Pb = PROJ + (size_t)b * SEQ * NPP + PC_KVA;
    { int l3 = F.lane; asm volatile("" : "+v"(l3));
      unsigned long long U = selm[l3];
      unsigned lo = (unsigned)U, hiw = (unsigned)(U >> 32);
#pragma unroll
      for (int o = 1; o < 64; o <<= 1) { lo |= __shfl_xor(lo, o); hiw |= __shfl_xor(hiw, o); }
      U = ((unsigned long long)(unsigned)__builtin_amdgcn_readfirstlane(hiw) << 32) | (unsigned)__builtin_amdgcn_readfirstlane(lo);
      const unsigned long long mine = selm[32 * (w & 1) + (l3 & 31)];
      Acc a; acc_init(a);
      flash_stage<1, 1, 8>(&a, qr, Pb + 2 * 64, Pb + 3 * 64, NPP, BitsIt{U}, DqSel{t - 4 * hi, mine}, 0x7fffffffu, slope2, slots, w, lane);
      const float l = a.l + __shfl_xor(a.l, 32), c = NSA_GATE(1) * (l > 0.f ? frcp(l) : 0.f);
#pragma unroll
      for (int r = 0; r < 16; ++r) { out0[r] += a.o0[r] * c; out1[r] += a.o1[r] * c; } }
    { Acc a; acc_init(a);
      flash_stage<1, 1, 8>(&a, qr, Pb + 4 * 64, Pb + 5 * 64, NPP, RangeIt{qblk >= 8 ? qblk - 8 : 0, qblk + 1}, DqCausal{t - 4 * hi}, 512u, slope2, slots, w, lane);
      const float l = a.l + __shfl_xor(a.l, 32), c = NSA_GATE(2) * (l > 0.f ? frcp(l) : 0.f);
#pragma unroll
      for (int r = 0; r < 16; ++r) { out0[r] += a.o0[r] * c; out1[r] += a.o1[r] * c; } }
    { int l4 = F.lane; asm volatile("" : "+v"(l4));
      store_ot(ws_bf(F, WS_AO) + ((size_t)b * SEQ + q0 + 32 * (w & 1) + (l4 & 31)) * D + h * 64, out0, out1, l4 >> 5); }
}

template <int MODE> __device__ __forceinline__ void ln_phase(Frame& F, const float* gam, const float* bet, bool write_xb) {
    const int lane = F.lane, w = F.wave, RPC = M / F.G, cu = blockIdx.x;
    const float* Y = (const float*)(F.ws + WS_Y);
    bf16_t* XB = ws_bf(F, WS_XB);
    LAS float* wrT = (LAS float*)F.lds;
    LAS int* histL = (LAS int*)(F.lds + 32768);
    int* route = (int*)(F.ws + WS_TAB + TB_ROUTE);
    if (MODE == 1) {
        const float* wr = inp(15);
        for (int i = F.tid; i < 8192; i += NTHREADS) wrT[(i & 7) * 1024 + (i >> 3)] = wr[i];
        if (F.tid < 8) histL[F.tid] = 0;
        LDS_WAIT(); __syncthreads();
    }
    f32x4 gv[4], bv[4];
#pragma unroll
    for (int j = 0; j < 4; ++j) { gv[j] = *(const f32x4*)(gam + 4 * lane + 256 * j); bv[j] = *(const f32x4*)(bet + 4 * lane + 256 * j); }
    for (int rr = w; rr < RPC; rr += NWAVES) {
        const size_t row = (size_t)cu * RPC + rr;
        f32x4 v[4];
        if (MODE == 2) {
            const int* rt = route + row * 8; const float g1 = __builtin_bit_cast(float, rt[2]), g2 = __builtin_bit_cast(float, rt[3]);
            const bf16_t* y1 = ws_bf(F, WS_XS) + (size_t)rt[4] * D; const bf16_t* y2 = ws_bf(F, WS_XS) + (size_t)rt[5] * D;
#pragma unroll
            for (int j = 0; j < 4; ++j) { const f32x4 x = *(const f32x4*)(F.out + row * D + 4 * lane + 256 * j);
                const u32x2 a = *(const u32x2*)(y1 + 4 * lane + 256 * j), b = *(const u32x2*)(y2 + 4 * lane + 256 * j);
                f32x4 fa = {__builtin_bit_cast(float, a.x << 16), __builtin_bit_cast(float, a.x & 0xffff0000u), __builtin_bit_cast(float, a.y << 16), __builtin_bit_cast(float, a.y & 0xffff0000u)};
                f32x4 fb = {__builtin_bit_cast(float, b.x << 16), __builtin_bit_cast(float, b.x & 0xffff0000u), __builtin_bit_cast(float, b.y << 16), __builtin_bit_cast(float, b.y & 0xffff0000u)};
                v[j] = x * DN_ALPHA + fa * g1 + fb * g2; }
        } else {
#pragma unroll
            for (int j = 0; j < 4; ++j) v[j] = *(const f32x4*)(Y + row * D + 4 * lane + 256 * j);
        }
        float s = 0.f;
#pragma unroll
        for (int j = 0; j < 4; ++j) s += (v[j][0] + v[j][1]) + (v[j][2] + v[j][3]);
        const float mean = wave_sum(s) * (1.0f / D); float s2 = 0.f;
#pragma unroll
        for (int j = 0; j < 4; ++j) { v[j] = v[j] - mean; s2 += (v[j][0] * v[j][0] + v[j][1] * v[j][1]) + (v[j][2] * v[j][2] + v[j][3] * v[j][3]); }
        const float rstd = __builtin_amdgcn_rsqf(wave_sum(s2) * (1.0f / D) + LN_EPS);
#pragma unroll
        for (int j = 0; j < 4; ++j) { v[j] = v[j] * rstd * gv[j] + bv[j]; *(f32x4*)(F.out + row * D + 4 * lane + 256 * j) = v[j]; }
        if (write_xb) {
#pragma unroll
            for (int j = 0; j < 4; ++j) { u32x2 o; o.x = pk2(v[j][0], v[j][1]); o.y = pk2(v[j][2], v[j][3]); *(u32x2*)(XB + row * D + 4 * lane + 256 * j) = o; }
        }
        if (MODE == 1) {
            float lg[8];
#pragma unroll
            for (int e = 0; e < 8; ++e) { float p = 0.f;
#pragma unroll
                for (int j = 0; j < 4; ++j) { const f32x4 ww = *(const LAS f32x4*)(wrT + e * 1024 + 4 * lane + 256 * j); p += (v[j][0] * ww[0] + v[j][1] * ww[1]) + (v[j][2] * ww[2] + v[j][3] * ww[3]); }
                lg[e] = wave_sum(p); }
            int e1 = 0; float l1 = lg[0];
#pragma unroll
            for (int e = 1; e < 8; ++e) if (lg[e] > l1) { l1 = lg[e]; e1 = e; }
            int e2 = -1; float l2 = -3.0e38f;
#pragma unroll
            for (int e = 0; e < 8; ++e) if (e != e1 && lg[e] > l2) { l2 = lg[e]; e2 = e; }
            const float ex = __expf(l2 - l1), g1 = 1.0f / (1.0f + ex), g2 = ex * g1;
            if (lane == 0) { int* rt = route + row * 8; rt[0] = e1; rt[1] = e2; rt[2] = __builtin_bit_cast(int, g1); rt[3] = __builtin_bit_cast(int, g2);
                __hip_atomic_fetch_add(histL + e1, 1, __ATOMIC_RELAXED, __HIP_MEMORY_SCOPE_WORKGROUP); __hip_atomic_fetch_add(histL + e2, 1, __ATOMIC_RELAXED, __HIP_MEMORY_SCOPE_WORKGROUP); }
        }
    }
    if (MODE == 1) { LDS_WAIT(); __syncthreads(); if (F.tid < 8) ((int*)(F.ws + WS_TAB + TB_HIST))[cu * 8 + F.tid] = histL[F.tid]; }
}

__device__ __forceinline__ void moe_dispatch(Frame& F) {
    const int lane = F.lane, w = F.wave, RPC = M / F.G, cu = blockIdx.x;
    LAS int* L = (LAS int*)F.lds;
    const int* hist = (const int*)(F.ws + WS_TAB + TB_HIST);
    int* route = (int*)(F.ws + WS_TAB + TB_ROUTE);
    if (F.tid < 8) { int pre = 0, tot = 0; for (int c = 0; c < F.G; ++c) { const int hc = hist[c * 8 + F.tid]; pre += (c < cu) ? hc : 0; tot += hc; } L[F.tid] = pre; L[8 + F.tid] = tot; }
    LDS_WAIT(); __syncthreads();
    if (F.tid == 0) { int sb = 0; for (int e = 0; e < 8; ++e) { L[16 + e] = sb; sb += ((L[8 + e] + 255) >> 8) << 8; } L[24] = sb;
        if (cu == 0) { int* meta = (int*)(F.ws + WS_TAB + TB_META); for (int e = 0; e < 9; ++e) meta[e] = L[16 + e]; for (int e = 0; e < 8; ++e) meta[16 + e] = L[8 + e];
            for (int e = 0; e < 8; ++e) for (int tl = L[16 + e] >> 8; tl < (L[17 + e] >> 8); ++tl) meta[32 + tl] = e; } }
    LDS_WAIT(); __syncthreads();
    if (w == 0) {
        const size_t tok = (size_t)cu * RPC + lane; int* rt = route + tok * 8; const int e1 = rt[0], e2 = rt[1];
        const unsigned long long lt = (1ull << lane) - 1ull, le = lt | (1ull << lane);
        int pos1 = 0, pos2 = 0;
#pragma unroll
        for (int e = 0; e < 8; ++e) { const unsigned long long m0 = __ballot(e1 == e), m1 = __ballot(e2 == e); const int base = L[16 + e] + L[e];
            if (e1 == e) pos1 = base + __builtin_popcountll(m0 & lt) + __builtin_popcountll(m1 & lt);
            if (e2 == e) pos2 = base + __builtin_popcountll(m0 & le) + __builtin_popcountll(m1 & lt); }
        rt[4] = pos1; rt[5] = pos2; L[32 + 2 * lane] = pos1; L[33 + 2 * lane] = pos2;
    }
    LDS_WAIT(); __syncthreads();
    const bf16_t* XB = ws_bf(F, WS_XB); bf16_t* XS = ws_bf(F, WS_XS);
    for (int a = w; a < 2 * RPC; a += NWAVES) { const size_t tok = (size_t)cu * RPC + (a >> 1); const int pos = L[32 + a];
        const u32x4* s = (const u32x4*)(XB + tok * D); u32x4* d = (u32x4*)(XS + (size_t)pos * D);
        d[lane] = s[lane]; d[64 + lane] = s[64 + lane]; }
}

constexpr int PH_PER_LAYER = 11, N_PHASES = 1 + DEPTH * PH_PER_LAYER;
struct Args { const float* in[25]; float* out; unsigned char* ws; int ph_lo, ph_hi, li, pad; };

__device__ __forceinline__ void run_phase(Frame& F, int ph) {
    using namespace pg8;
#ifndef PHSEL
#define PHSEL 0xFFF
#endif
    if (ph == 0) { int z0 = 0; asm volatile("" : "+v"(z0)); F.lane = (int)__builtin_amdgcn_mbcnt_hi(~0u, __builtin_amdgcn_mbcnt_lo(~0u, (unsigned)z0)); F.tid = F.wave * 64 + F.lane; if (PHSEL & 0x800) p0_prologue(F); return; }
    const int L = (ph - 1) / PH_PER_LAYER, k = (ph - 1) % PH_PER_LAYER;
    const bool moe = (L & 1) != 0;
    int cid = (int)blockIdx.x; asm volatile("" : "+s"(cid));
    { int wv_ = F.wave; asm volatile("" : "+s"(wv_)); F.wave = wv_; }
    { int z_ = 0; asm volatile("" : "+v"(z_)); F.lane = (int)__builtin_amdgcn_mbcnt_hi(~0u, __builtin_amdgcn_mbcnt_lo(~0u, (unsigned)z_)); F.tid = F.wave * 64 + F.lane; }
    { unsigned char* w_ = F.ws; asm volatile("" : "+s"(w_)); F.ws = w_; }
    unsigned char* ws = F.ws;
    switch (k) {
    case 0: if (PHSEL & (1 << 0)) {
        Gemm g{ws_bf(F, WS_XB), ws_bf(F, L ? WS_WIN1 : WS_WIN0), D, D}; StaticOrder S; S.init(M / 256, NPP / 256, F.G, cid);
        EpiBf16<0> E{ws_bf(F, WS_PROJ), NPP};
        gemm_phase(F.lds, g, S, E, F.wave);
    } break;
    case 1: if (PHSEL & (1 << 1)) {
        const float lam_init = 0.8f - 0.6f * __expf(-0.3f * (float)L);
        float lam;
        { const float* dl = inp(6) + L * 128; const int l = F.lane & 31; const float a = dl[l] * dl[32 + l], b = dl[64 + l] * dl[96 + l];
          float sa = (F.lane < 32) ? a : 0.f, sb = (F.lane < 32) ? b : 0.f; sa = wave_sum(sa); sb = wave_sum(sb); lam = __expf(sa) - __expf(sb) + lam_init; }
#ifndef PROBE_ATT1
#define PROBE_ATT1 0
#endif
#pragma nounroll
        for (int r1 = 0; r1 < 1 + (PROBE_ATT1 & 1); ++r1)
        for (int u = cid; u < 256; u += F.G) { const int b = u >> 6, h = (u >> 4) & 3, s = u & 15;
            diff_unit(F, L, b, h, 31 - s, lam, 1.0f - lam_init); diff_unit(F, L, b, h, s, lam, 1.0f - lam_init); }
#pragma nounroll
        for (int r2 = 0; r2 < 1 + ((PROBE_ATT1 >> 1) & 1); ++r2)
        for (int u = cid; u < 128; u += F.G) compress_unit(F, L, u >> 6, (u >> 4) & 3, u & 15);
#pragma nounroll
        for (int r3 = 0; r3 < 1 + ((PROBE_ATT1 >> 2) & 1); ++r3)
        for (int u = cid; u < 512; u += F.G) swa_unit(F, L, u >> 7, (u >> 6) & 1, u & 63);
    } break;
    case 2: if (PHSEL & (1 << 2)) {
        for (int u = cid; u < 256; u += F.G) nsa_unit(F, L, u >> 6, u & 63);
    } break;
    case 3: if (PHSEL & (1 << 3)) {
        Gemm g{ws_bf(F, WS_AO), ws_bf(F, L ? WS_WOUT1 : WS_WOUT0), D, D}; StaticOrder S; S.init(M / 256, D / 256, F.G, cid);
        EpiResid<0> E{L ? F.out : inp(0), (float*)(ws + WS_Y), nullptr, D};
        gemm_phase(F.lds, g, S, E, F.wave);
    } break;
    case 4: if (PHSEL & (1 << 4)) {
        if (moe) ln_phase<1>(F, inp(10) + L * D, inp(11) + L * D, true); else ln_phase<0>(F, inp(10) + L * D, inp(11) + L * D, true);
        cvt_rows(inp(1) + (size_t)L * M * PLE, ws_bf(F, WS_PB), (size_t)M * PLE / 8, (size_t)blockIdx.x * NTHREADS + F.tid, (size_t)F.G * NTHREADS);
    } break;
    case 5: if (PHSEL & (1 << 5)) {
        if (!moe) { Gemm g{ws_bf(F, WS_XB), ws_bf(F, WS_FGU), D, D}; StaticOrder S; S.init(M / 256, 2 * FF / 256, F.G, cid);
            EpiBf16<1> E{ws_bf(F, WS_H), FF}; gemm_phase(F.lds, g, S, E, F.wave); }
        else moe_dispatch(F);
    } break;
    case 6: if (PHSEL & (1 << 6)) {
        if (!moe) { Gemm g{ws_bf(F, WS_H), ws_bf(F, WS_FD), FF, FF}; StaticOrder S; S.init(M / 256, D / 256, F.G, cid);
            EpiResid<0> E{F.out, (float*)(ws + WS_Y), nullptr, D}; gemm_phase(F.lds, g, S, E, F.wave); }
        else { const int* meta = (const int*)(ws + WS_TAB + TB_META);
            MoeOrder S; S.so.init(__builtin_amdgcn_readfirstlane(meta[8]) >> 8, 2 * FE / 256, F.G, cid); S.tile_e = meta + 32;
            Gemm g{ws_bf(F, WS_XS), ws_bf(F, WS_MOE_GU), D, D}; EpiBf16<1> E{ws_bf(F, WS_HM), FE}; gemm_phase(F.lds, g, S, E, F.wave); }
    } break;
    case 7: if (PHSEL & (1 << 7)) {
        if (moe) { const int* meta = (const int*)(ws + WS_TAB + TB_META);
            MoeOrder S; S.so.init(__builtin_amdgcn_readfirstlane(meta[8]) >> 8, D / 256, F.G, cid); S.tile_e = meta + 32;
            Gemm g{ws_bf(F, WS_HM), ws_bf(F, WS_MOE_D), FE, FE}; EpiBf16<0> E{ws_bf(F, WS_XS), D}; gemm_phase(F.lds, g, S, E, F.wave); }
    } break;
    case 8: if (PHSEL & (1 << 8)) {
        if (moe) ln_phase<2>(F, inp(19) + L * D, inp(20) + L * D, true); else ln_phase<0>(F, inp(19) + L * D, inp(20) + L * D, true);
        __syncthreads();
        Gemm g{ws_bf(F, WS_PB), ws_bf(F, L ? WS_PLEP1 : WS_PLEP0), PLE, PLE}; StaticOrder S; S.init(M / 256, D / 256, F.G, cid);
        EpiBf16<0> E{ws_bf(F, WS_U), D}; gemm_phase(F.lds, g, S, E, F.wave);
    } break;
    case 9: if (PHSEL & (1 << 9)) {
        Gemm g{ws_bf(F, WS_XB), ws_bf(F, L ? WS_PLEG1 : WS_PLEG0), D, D}; StaticOrder S; S.init(M / 256, D / 256, F.G, cid);
        EpiResid<1> E{F.out, (float*)(ws + WS_Y), ws_bf(F, WS_U), D}; gemm_phase(F.lds, g, S, E, F.wave);
    } break;
    case 10: if (PHSEL & (1 << 10)) {
        ln_phase<0>(F, inp(23) + L * D, inp(24) + L * D, L + 1 < DEPTH);
    } break;
    default: break;
    }
}
__device__ __forceinline__ bool phase_empty(int ph) { if (ph == 0) return false; const int L = (ph - 1) / PH_PER_LAYER, k = (ph - 1) % PH_PER_LAYER; return k == 7 && (L & 1) == 0; }

__global__ void __launch_bounds__(NTHREADS, 2) mk_fwd(Args args) {
    extern __shared__ __attribute__((aligned(16))) unsigned char lds_raw[];
    Frame F;
    F.lds = (LAS unsigned char*)lds_raw;
    F.tid = threadIdx.x; F.lane = F.tid & 63; F.wave = __builtin_amdgcn_readfirstlane(F.tid >> 6);
    { const int bx = blockIdx.x; F.vcu = (bx % 8) * (GRID / 8) + bx / 8; }
    F.ws = args.ws; F.out = args.out;
    for (int u = F.tid; u < (LDS_BYTES - LDSCTL_OFF) / 4; u += NTHREADS) ((LAS unsigned*)(F.lds + LDSCTL_OFF))[u] = 0u;
    __syncthreads();
    unsigned* ctl = (unsigned*)(F.ws + WS_CTL);
    XcdBarrier bar; bar.bar = ctl + CW_BAR + args.li * XCD_BAR_WORDS; bar.x = 0; bar.st = nullptr;
    const bool multi = (args.ph_hi - args.ph_lo) > 1;
    if (multi) bar = xcd_barrier_post(ctl + CW_BAR + args.li * XCD_BAR_WORDS, (volatile LAS unsigned*)(F.lds + MISC_OFF) + 8);
    bool first = true;
    for (int ph = args.ph_lo; ph < args.ph_hi; ++ph) {
        if (phase_empty(ph)) continue;
        int nrep = 1;
#ifdef PROBE_REP
        nrep += (ph == 0) ? ((PROBE_REP >> 11) & 1) : ((PROBE_REP >> ((ph - 1) % PH_PER_LAYER)) & 1);
#endif
#pragma nounroll
        for (int rep = 0; rep < nrep; ++rep) {
            if (!first) { int z_ = 0; asm volatile("" : "+v"(z_)); const int ln = (int)__builtin_amdgcn_mbcnt_hi(~0u, __builtin_amdgcn_mbcnt_lo(~0u, (unsigned)z_)); xcd_barrier(bar, F.wave == 0 && ln == 0); }
            run_phase(F, ph);
            first = false;
        }
    }
}

extern "C" void kernel_launch(void* const* d_in, const int* in_sizes, int n_in, void* d_out, int out_size, void* d_ws, size_t ws_size, hipStream_t stream) {
    static int grid = 0;
    if (grid == 0) {
        if (n_in != 25 || out_size != M * D || ws_size < WS_END) { fprintf(stderr, "kernel_launch: unexpected sizes n_in %d out %d ws %zu (need %zu)\n", n_in, out_size, ws_size, (size_t)WS_END); grid = -1; return; }
        int dev = 0, cus = 0, per_cu = 0;
        if (hipGetDevice(&dev) != hipSuccess || hipDeviceGetAttribute(&cus, hipDeviceAttributeMultiprocessorCount, dev) != hipSuccess) { grid = -1; return; }
        if (hipFuncSetAttribute((const void*)mk_fwd, hipFuncAttributeMaxDynamicSharedMemorySize, LDS_BYTES) != hipSuccess) { fprintf(stderr, "kernel_launch: hipFuncSetAttribute failed\n"); grid = -1; return; }
        if (hipOccupancyMaxActiveBlocksPerMultiprocessor(&per_cu, (const void*)mk_fwd, NTHREADS, LDS_BYTES) != hipSuccess || per_cu < 1) { fprintf(stderr, "kernel_launch: occupancy query says %d blocks per CU\n", per_cu); (void)hipGetLastError(); grid = -1; return; }
        if (cus < 256) { fprintf(stderr, "kernel_launch: needs 256 CUs, device has %d\n", cus); grid = -1; return; }
        grid = 256;
    }
    if (grid < 0) return;
    (void)hipMemsetAsync((char*)d_ws + WS_CTL, 0, CTL_ZERO_BYTES, stream);
    Args a{};
    for (int i = 0; i < 25; ++i) a.in[i] = (const float*)d_in[i];
    a.out = (float*)d_out; a.ws = (unsigned char*)d_ws;
#if MK_N_LAUNCHES == 1
    a.ph_lo = 0; a.ph_hi = N_PHASES; a.li = 0;
    hipLaunchKernelGGL(mk_fwd, dim3(grid), dim3(NTHREADS), LDS_BYTES, stream, a);
#else
    for (int ph = 0; ph < N_PHASES; ++ph) { a.ph_lo = ph; a.ph_hi = ph + 1; a.li = 0;
        hipLaunchKernelGGL(mk_fwd, dim3(grid), dim3(NTHREADS), LDS_BYTES, stream, a); }
#endif
}
```
